# Optimizing an MI355X kernel written in HIP

```python
import math
import jax, jax.numpy as jnp
from jax import lax
import numpy as np

D_MODEL = 1024
BATCH = 4
SEQ = 8192
DEPTH = 2

N_MIXERS = 2
POOL_WINDOWS = (2, 4, 8, 16)
POOL_GROUPS = len(POOL_WINDOWS)
POOL_GROUP_DIM = D_MODEL // POOL_GROUPS
RET_HEADS = 4
RET_QK_DIM = D_MODEL // RET_HEADS
RET_V_DIM = 2 * D_MODEL // RET_HEADS
RET_QK_TOTAL = RET_HEADS * RET_QK_DIM
RET_V_TOTAL = RET_HEADS * RET_V_DIM
RET_IN_DIM = 2 * RET_QK_TOTAL + 2 * RET_V_TOTAL
RET_CHUNK = 128
ROPE_BASE = 10000.0
D_FF = 2816
CONV_WIDTH = 3
EPS = 1e-6
N_NORMS = 4
N_POOL_LAYERS = (DEPTH + N_MIXERS - 1) // N_MIXERS
N_RET_LAYERS = DEPTH // N_MIXERS

kernel_name = "hybrid_pool_retention_convglu"


def rms_norm(x, gain):
    xf = x.astype(jnp.float32)
    var = jnp.mean(xf * xf, axis=-1, keepdims=True)
    return (xf * lax.rsqrt(var + EPS) * gain.astype(jnp.float32)).astype(x.dtype)


def pool_mixer(h, w_groups, scale):
    b, s, d = h.shape
    hf = h.astype(jnp.float32)
    cs = jnp.cumsum(hf, axis=1)
    t = jnp.arange(s)
    parts = []
    for g, win in enumerate(POOL_WINDOWS):
        lo, hi = g * POOL_GROUP_DIM, (g + 1) * POOL_GROUP_DIM
        c = cs[..., lo:hi]
        c_shift = jnp.pad(c, ((0, 0), (win, 0), (0, 0)))[:, :s]
        count = jnp.minimum(t + 1, win).astype(jnp.float32)[None, :, None]
        parts.append((c - c_shift) / count - hf[..., lo:hi])
    diff = jnp.concatenate(parts, axis=-1).reshape(b, s, POOL_GROUPS, POOL_GROUP_DIM)
    y = jnp.einsum('bsgc,gcd->bsgd', diff, w_groups.astype(jnp.float32)).reshape(b, s, d)
    return (y * scale.astype(jnp.float32)).astype(h.dtype)


def rotary(x, positions):
    dh = x.shape[-1]
    inv_freq = ROPE_BASE ** (-jnp.arange(0, dh, 2, dtype=jnp.float32) / dh)
    ang = positions.astype(jnp.float32)[..., None] * inv_freq
    cos = jnp.cos(ang)[:, :, None, :]
    sin = jnp.sin(ang)[:, :, None, :]
    x1, x2 = x[..., : dh // 2], x[..., dh // 2:]
    return jnp.concatenate([x1 * cos - x2 * sin, x2 * cos + x1 * sin], axis=-1)


def retention(h, positions, w_in, gn_gain, w_out):
    b, s, _ = h.shape
    n_chunks = s // RET_CHUNK
    proj = (h @ w_in).astype(jnp.float32)
    q, k, v, g = jnp.split(proj, [RET_QK_TOTAL, 2 * RET_QK_TOTAL, 2 * RET_QK_TOTAL + RET_V_TOTAL], axis=-1)
    q = rotary(q.reshape(b, s, RET_HEADS, RET_QK_DIM), positions) * (RET_QK_DIM ** -0.5)
    k = rotary(k.reshape(b, s, RET_HEADS, RET_QK_DIM), positions)
    v = v.reshape(b, s, RET_HEADS, RET_V_DIM)

    def to_chunks(a):
        return a.reshape(b, n_chunks, RET_CHUNK, RET_HEADS, a.shape[-1]).transpose(1, 0, 3, 2, 4)

    qc, kc, vc = to_chunks(q), to_chunks(k), to_chunks(v)

    log_gamma = jnp.log(1.0 - 2.0 ** (-5.0 - jnp.arange(RET_HEADS, dtype=jnp.float32)))
    i = jnp.arange(RET_CHUNK, dtype=jnp.float32)
    rel = i[:, None] - i[None, :]
    intra_decay = jnp.where(rel >= 0, jnp.exp(jnp.maximum(rel, 0.0) * log_gamma[:, None, None]), 0.0)
    cross_decay = jnp.exp((i + 1.0) * log_gamma[:, None])[None, :, :, None]
    in_decay = jnp.exp((RET_CHUNK - 1.0 - i) * log_gamma[:, None])[None, :, :, None]
    chunk_decay = jnp.exp(RET_CHUNK * log_gamma)[None, :, None, None]

    def step(state, xs):
        qb, kb, vb = xs
        scores = jnp.einsum('bhid,bhjd->bhij', qb, kb) * intra_decay[None]
        out = jnp.einsum('bhij,bhjv->bhiv', scores, vb) \
            + jnp.einsum('bhid,bhdv->bhiv', qb, state) * cross_decay
        state = state * chunk_decay + jnp.einsum('bhjd,bhjv->bhdv', kb * in_decay, vb)
        return state, out

    state0 = jnp.zeros((b, RET_HEADS, RET_QK_DIM, RET_V_DIM), jnp.float32)
    _, o = lax.scan(step, state0, (qc, kc, vc))
    o = o.transpose(1, 0, 3, 2, 4).reshape(b, s, RET_HEADS, RET_V_DIM)
    mu = jnp.mean(o, axis=-1, keepdims=True)
    var = jnp.mean(jnp.square(o - mu), axis=-1, keepdims=True)
    o = ((o - mu) * lax.rsqrt(var + EPS)).reshape(b, s, RET_V_TOTAL) * gn_gain.astype(jnp.float32)
    y = jax.nn.silu(g) * o
    return (y.astype(h.dtype) @ w_out)


def conv_glu(h, w_up, conv_w, conv_b, w_down):
    s = h.shape[1]
    u = h @ w_up
    up = jnp.pad(u, ((0, 0), (CONV_WIDTH - 1, 0), (0, 0)))
    c = conv_b
    for tap in range(CONV_WIDTH):
        c = c + up[:, tap:tap + s] * conv_w[tap]
    gate, val = jnp.split(c, 2, axis=-1)
    return (jax.nn.silu(gate) * val) @ w_down


def setup_inputs(seed: int = 0) -> dict:
    key = jax.random.key(seed)
    ks = jax.random.split(key, 14)
    f32 = jnp.float32
    x = jax.random.normal(ks[0], (BATCH, SEQ, D_MODEL), f32)
    offsets = jax.random.randint(ks[1], (BATCH, 1), 0, 1024, dtype=jnp.int32)
    positions = (jnp.arange(SEQ, dtype=jnp.int32)[None, :] + offsets).astype(jnp.int32)
    norm_gain = 1.0 + 0.05 * jax.random.normal(ks[2], (DEPTH, N_NORMS, D_MODEL), f32)
    pool_w = jax.random.normal(ks[3], (N_POOL_LAYERS, POOL_GROUPS, POOL_GROUP_DIM, POOL_GROUP_DIM), f32) * POOL_GROUP_DIM ** -0.5
    pool_scale = 1.0 + 0.1 * jax.random.normal(ks[4], (N_POOL_LAYERS, D_MODEL), f32)
    ret_w_in = jax.random.normal(ks[5], (N_RET_LAYERS, D_MODEL, RET_IN_DIM), f32) * D_MODEL ** -0.5
    ret_gn_gain = 1.0 + 0.05 * jax.random.normal(ks[6], (N_RET_LAYERS, RET_V_TOTAL), f32)
    ret_w_out = jax.random.normal(ks[7], (N_RET_LAYERS, RET_V_TOTAL, D_MODEL), f32) * RET_V_TOTAL ** -0.5
    mlp_w_up = jax.random.normal(ks[8], (DEPTH, D_MODEL, 2 * D_FF), f32) * D_MODEL ** -0.5
    mlp_conv_w = jax.random.normal(ks[9], (DEPTH, CONV_WIDTH, 2 * D_FF), f32) * CONV_WIDTH ** -0.5
    mlp_conv_b = 0.02 * jax.random.normal(ks[10], (DEPTH, 2 * D_FF), f32)
    mlp_w_down = jax.random.normal(ks[11], (DEPTH, D_FF, D_MODEL), f32) * D_FF ** -0.5
    return {"x": x, "positions": positions, "norm_gain": norm_gain,
            "pool_w": pool_w, "pool_scale": pool_scale,
            "ret_w_in": ret_w_in, "ret_gn_gain": ret_gn_gain, "ret_w_out": ret_w_out,
            "mlp_w_up": mlp_w_up, "mlp_conv_w": mlp_conv_w, "mlp_conv_b": mlp_conv_b,
            "mlp_w_down": mlp_w_down}


def reference(x, positions, norm_gain, pool_w, pool_scale, ret_w_in, ret_gn_gain,
              ret_w_out, mlp_w_up, mlp_conv_w, mlp_conv_b, mlp_w_down):
    for layer in range(DEPTH):
        gains = norm_gain[layer]
        h = rms_norm(x, gains[0])
        j = layer // N_MIXERS
        if layer % N_MIXERS == 0:
            m = pool_mixer(h, pool_w[j], pool_scale[j])
        else:
            m = retention(h, positions, ret_w_in[j], ret_gn_gain[j], ret_w_out[j])
        x = x + rms_norm(m, gains[1])
        h = rms_norm(x, gains[2])
        f = conv_glu(h, mlp_w_up[layer], mlp_conv_w[layer], mlp_conv_b[layer], mlp_w_down[layer])
        x = x + rms_norm(f, gains[3])
    return x
```

```cpp
#include <hip/hip_runtime.h>
#include <cstdio>
#include <cstdint>


#ifndef MK_ONE_LAUNCH
#define MK_ONE_LAUNCH 1
#endif

#define LAS __attribute__((address_space(3)))
#define GAS __attribute__((address_space(1)))
typedef unsigned short bf16_t;
typedef short bf16x8 __attribute__((ext_vector_type(8)));
typedef float f32x4 __attribute__((ext_vector_type(4)));
typedef float f32x2 __attribute__((ext_vector_type(2)));
typedef unsigned u32x4 __attribute__((ext_vector_type(4)));
typedef unsigned u32x2 __attribute__((ext_vector_type(2)));

constexpr int BATCH = 4, SEQ = 8192, D = 1024, M = BATCH * SEQ;
constexpr int FF = 2816, FF2 = 5632, NH = 4, DK = 256, DV = 512, VTOT = 2048, RIN = 6144, NCH = 64;
constexpr float EPS = 1e-6f;
__device__ __forceinline__ float l2gamma(int h) { return h == 0 ? -0.04580368961312479f : h == 1 ? -0.02272007650008353f : h == 2 ? -0.011315313227834146f : -0.005646563141142063f; }

typedef __bf16 bf16x2_t __attribute__((ext_vector_type(2)));
__device__ __forceinline__ unsigned cvt_pk_bf16(float lo, float hi) { const f32x2 v = {lo, hi}; return __builtin_bit_cast(unsigned, __builtin_convertvector(v, bf16x2_t)); }
__device__ __forceinline__ unsigned f2bf(float f) { unsigned u = __builtin_bit_cast(unsigned, f); return (u + 0x7fffu + ((u >> 16) & 1u)) >> 16; }
__device__ __forceinline__ float bf2f(unsigned short b) { return __builtin_bit_cast(float, ((unsigned)b) << 16); }
__device__ __forceinline__ float sigmoidf_(float x) { return __builtin_amdgcn_rcpf(1.0f + __builtin_amdgcn_exp2f(-1.4426950408889634f * x)); }

namespace pg8 {
constexpr int BM = 256, BK = 64, HALF = 128, HTB = HALF * BK * 2, STAGE_BYTES = 8 * HTB, NXCD = 8, WGM = 8;
__host__ __device__ __forceinline__ int lds_byte(int r, int c) { const int st = (r >> 4) * 2 + (c >> 5), rr = r & 15, cc = c & 31, ob = rr * 64 + cc * 2; return st * 1024 + (ob ^ (((ob >> 9) & 1) << 5)); }
__host__ __device__ __forceinline__ void stage_rc(int b, int& R, int& C) { const int st = b / 1024, sb = b % 1024, swz = sb ^ (((sb >> 9) & 1) << 5); R = (st >> 1) * 16 + swz / 64; C = (st & 1) * 32 + (swz % 64) / 2; }
__host__ __device__ __forceinline__ int perm32(int rho) { const int n = rho >> 4, i = rho & 15; return 8 * (i >> 2) + 4 * n + (i & 3); }

struct Unit { int pm, pn; };
struct Gemm { const bf16_t* A; const bf16_t* Bt; int M, N, K, lda, apn; };

struct StaticOrder {
    int nM, nN, nwg, G, c;
    __host__ __device__ void init(int M_, int N_, int G_, int c_) { nM = M_ / BM; nN = N_ / BM; nwg = nM * nN; G = G_; c = c_; }
    __host__ __device__ bool next(int i, Unit& u) const {
        const long L = (long)i * G + c; if (L >= nwg) return false;
        int wgid = (int)L; { const int q = nwg / NXCD, r = nwg % NXCD, xcd = wgid % NXCD, off = wgid / NXCD; wgid = (xcd < r ? xcd * (q + 1) : r * (q + 1) + (xcd - r) * q) + off; }
        const int nig = WGM * nN, gid = wgid / nig, fm = gid * WGM, gsz = (nM - fm) < WGM ? (nM - fm) : WGM;
        u.pm = fm + ((wgid % nig) % gsz); u.pn = (wgid % nig) / gsz; return true;
    }
};

typedef f32x4 Acc[2][2][4][2];

struct EpiF32 {
    static constexpr bool PERM = false;
    float* C; int ldc;
    __device__ __forceinline__ void operator()(Acc& acc, const Unit& u, int wr, int wc, int fr, int fq, LAS unsigned char*, int, int) const {
        const int row0 = u.pm * BM + wr * 64 + fr, col0 = u.pn * BM + wc * 32 + 4 * fq;
#pragma unroll
        for (int ai = 0; ai < 2; ++ai)
#pragma unroll
            for (int m = 0; m < 4; ++m) { float* rowp = C + (size_t)(row0 + ai * HALF + m * 16) * ldc + col0;
#pragma unroll
                for (int bj = 0; bj < 2; ++bj)
#pragma unroll
                    for (int n = 0; n < 2; ++n) *(f32x4*)(rowp + bj * HALF + n * 16) = acc[ai][bj][m][n]; }
    }
};

struct EpiConvGlu {
    static constexpr bool PERM = true;
    bf16_t* act; float* halo; const float* cw; const float* cb;
    __device__ __forceinline__ void operator()(Acc& acc, const Unit& u, int wr, int wc, int fr, int fq, LAS unsigned char* xl, int wid, int lane) const {
        LAS f32x4* EX = (LAS f32x4*)xl;
        const int jc = u.pn * 128 + wc * 32 + 8 * fq;
        if (fr >= 14) {
#pragma unroll
            for (int ai = 0; ai < 2; ++ai)
#pragma unroll
                for (int bj = 0; bj < 2; ++bj)
#pragma unroll
                    for (int n = 0; n < 2; ++n) EX[((((wid * 2 + ai) * 2 + bj) * 2 + n) * 4 + fq) * 2 + (fr - 14)] = acc[ai][bj][3][n];
            if (wr == 1) {
#pragma unroll
                for (int bj = 0; bj < 2; ++bj)
#pragma unroll
                    for (int n = 0; n < 2; ++n) *(f32x4*)(halo + (size_t)(u.pm * 4 + 2 + (fr - 14)) * FF2 + bj * FF + jc + 4 * n) = acc[1][bj][3][n];
            }
        }
        if (wr == 0 && fr < 2) {
#pragma unroll
            for (int bj = 0; bj < 2; ++bj)
#pragma unroll
                for (int n = 0; n < 2; ++n) *(f32x4*)(halo + (size_t)(u.pm * 4 + fr) * FF2 + bj * FF + jc + 4 * n) = acc[0][bj][0][n];
        }
        asm volatile("s_waitcnt lgkmcnt(0)" ::: "memory"); __builtin_amdgcn_s_barrier(); asm volatile("" ::: "memory");
        const int idx1 = ((((lane & 15) - 1) & 15) | (lane & 48)) << 2, idx2 = ((((lane & 15) - 2) & 15) | (lane & 48)) << 2;
        const int srcw = (1 - wr) * 4 + wc;
#pragma unroll
        for (int n = 0; n < 2; ++n) {
            f32x4 wg[3], wv[3];
#pragma unroll
            for (int t = 0; t < 3; ++t) { wg[t] = *(const f32x4*)(cw + t * FF2 + jc + 4 * n); wv[t] = *(const f32x4*)(cw + t * FF2 + FF + jc + 4 * n); }
            const f32x4 bg = *(const f32x4*)(cb + jc + 4 * n), bv = *(const f32x4*)(cb + FF + jc + 4 * n);
#pragma unroll
            for (int ai = 0; ai < 2; ++ai) {
                f32x4 pg = (f32x4){0.f, 0.f, 0.f, 0.f}, pv = pg;
                if (!(ai == 0 && wr == 0)) { const int as = ai & wr;
                    pg = EX[((((srcw * 2 + as) * 2 + 0) * 2 + n) * 4 + fq) * 2 + (fr & 1)];
                    pv = EX[((((srcw * 2 + as) * 2 + 1) * 2 + n) * 4 + fq) * 2 + (fr & 1)]; }
#pragma unroll
                for (int m = 0; m < 4; ++m) {
                    const f32x4 xg = acc[ai][0][m][n], xv = acc[ai][1][m][n];
                    f32x4 a;
#pragma unroll
                    for (int e = 0; e < 4; ++e) {
                        const float t1g = fr == 15 ? pg[e] : xg[e], t2g = fr >= 14 ? pg[e] : xg[e], t1v = fr == 15 ? pv[e] : xv[e], t2v = fr >= 14 ? pv[e] : xv[e];
                        const float p1g = __builtin_bit_cast(float, __builtin_amdgcn_ds_bpermute(idx1, __builtin_bit_cast(int, t1g)));
                        const float p2g = __builtin_bit_cast(float, __builtin_amdgcn_ds_bpermute(idx2, __builtin_bit_cast(int, t2g)));
                        const float p1v = __builtin_bit_cast(float, __builtin_amdgcn_ds_bpermute(idx1, __builtin_bit_cast(int, t1v)));
                        const float p2v = __builtin_bit_cast(float, __builtin_amdgcn_ds_bpermute(idx2, __builtin_bit_cast(int, t2v)));
                        const float cg = bg[e] + wg[0][e] * p2g + wg[1][e] * p1g + wg[2][e] * xg[e];
                        const float cv = bv[e] + wv[0][e] * p2v + wv[1][e] * p1v + wv[2][e] * xv[e];
                        a[e] = cg * sigmoidf_(cg) * cv;
                    }
                    const bool skip = (ai == 0) && (wr == 0) && (m == 0) && (fr < 2);
                    if (!skip) { u32x2 w; w.x = cvt_pk_bf16(a[0], a[1]); w.y = cvt_pk_bf16(a[2], a[3]);
                        *(u32x2*)(act + (size_t)(u.pm * BM + ai * HALF + wr * 64 + m * 16 + fr) * FF + jc + 4 * n) = w; }
                    pg = xg; pv = xv;
                }
            }
        }
    }
};

__device__ __forceinline__ void tstore16(LAS unsigned short* T, const f32x4 (&v)[4], bf16_t* out, int chan0, int n, size_t t0, int fr, int fq, int lane) {
#pragma unroll
    for (int m = 0; m < 4; ++m)
#pragma unroll
        for (int e = 0; e < 4; ++e) T[(4 * fq + e) * 72 + 16 * m + fr] = (unsigned short)f2bf(v[m][e]);
    asm volatile("s_waitcnt lgkmcnt(0)" ::: "memory");
    u32x4 dd[2];
#pragma unroll
    for (int k = 0; k < 2; ++k) dd[k] = *(const LAS u32x4*)(T + (8 * k + (lane >> 3)) * 72 + 8 * (lane & 7));
    asm volatile("s_waitcnt lgkmcnt(0)" ::: "memory");
#pragma unroll
    for (int k = 0; k < 2; ++k) { const int c = 8 * k + (lane >> 3);
        const u32x4 d = dd[k];
        const int col = 8 * (c >> 2) + 4 * n + (c & 3);
        *(u32x4*)(out + (size_t)(chan0 + col) * M + t0 + 8 * (lane & 7)) = d; }
}

struct EpiRetA {
    static constexpr bool PERM = true;
    bf16_t *Q, *K, *KT, *VT; const int* pos;
    __device__ __forceinline__ void operator()(Acc& acc, const Unit& u, int wr, int wc, int fr, int fq, LAS unsigned char* xl, int wid, int lane) const {
        LAS unsigned short* T = (LAS unsigned short*)(xl + 8192 + wid * 2304);
        const int pn = u.pn;
        if (pn < 8) {
            const bool isk = pn >= 4; const int h = pn & 3; const float sc = isk ? 1.0f : 0.0625f;
            float fv[2][4];
#pragma unroll
            for (int n = 0; n < 2; ++n)
#pragma unroll
                for (int e = 0; e < 4; ++e) fv[n][e] = __builtin_amdgcn_exp2f(-(float)(wc * 32 + 8 * fq + 4 * n + e) * (13.287712379549449f / 128.0f)) * 0.15915494309189535f;
            bf16_t* dst = isk ? K : Q;
#pragma unroll
            for (int ai = 0; ai < 2; ++ai)
#pragma unroll
                for (int m = 0; m < 4; ++m) { const int row = u.pm * BM + ai * HALF + wr * 64 + m * 16 + fr; const float p = (float)pos[row];
#pragma unroll
                    for (int n = 0; n < 2; ++n)
#pragma unroll
                        for (int e = 0; e < 4; ++e) { const float rev = __builtin_amdgcn_fractf(p * fv[n][e]); const float c = __builtin_amdgcn_cosf(rev) * sc, s = __builtin_amdgcn_sinf(rev) * sc;
                            const float x1 = acc[ai][0][m][n][e], x2 = acc[ai][1][m][n][e]; acc[ai][0][m][n][e] = x1 * c - x2 * s; acc[ai][1][m][n][e] = x2 * c + x1 * s; }
#pragma unroll
                    for (int bj = 0; bj < 2; ++bj) { const f32x4 v0 = acc[ai][bj][m][0], v1 = acc[ai][bj][m][1]; u32x4 w; w.x = cvt_pk_bf16(v0[0], v0[1]); w.y = cvt_pk_bf16(v0[2], v0[3]); w.z = cvt_pk_bf16(v1[0], v1[1]); w.w = cvt_pk_bf16(v1[2], v1[3]);
                        *(u32x4*)(dst + (size_t)row * D + 256 * h + bj * HALF + wc * 32 + 8 * fq) = w; } }
            if (isk) {
                float dk[4];
#pragma unroll
                for (int m = 0; m < 4; ++m) dk[m] = __builtin_amdgcn_exp2f((float)(127 - (64 * wr + 16 * m + fr)) * l2gamma(h));
#pragma unroll
                for (int ai = 0; ai < 2; ++ai)
#pragma unroll
                    for (int bj = 0; bj < 2; ++bj)
#pragma unroll
                        for (int n = 0; n < 2; ++n) { f32x4 v[4];
#pragma unroll
                            for (int m = 0; m < 4; ++m) v[m] = acc[ai][bj][m][n] * dk[m];
                            tstore16(T, v, KT, 256 * h + bj * HALF + wc * 32, n, (size_t)u.pm * BM + ai * HALF + wr * 64, fr, fq, lane); }
            }
        } else {
#pragma unroll
            for (int ai = 0; ai < 2; ++ai)
#pragma unroll
                for (int bj = 0; bj < 2; ++bj)
#pragma unroll
                    for (int n = 0; n < 2; ++n) { f32x4 v[4];
#pragma unroll
                        for (int m = 0; m < 4; ++m) v[m] = acc[ai][bj][m][n];
                        tstore16(T, v, VT, 256 * (pn - 8) + bj * HALF + wc * 32, n, (size_t)u.pm * BM + ai * HALF + wr * 64, fr, fq, lane); }
        }
    }
};

struct EpiRetB {
    static constexpr bool PERM = true;
    const bf16_t* O; const long long* stats; const float* gn; bf16_t* Y;
    __device__ __forceinline__ void operator()(Acc& acc, const Unit& u, int wr, int wc, int fr, int fq, LAS unsigned char*, int, int) const {
        const int h = u.pn >> 1, cb0 = u.pn * BM + wc * 32 + 8 * fq;
        f32x4 gg[2][2];
#pragma unroll
        for (int bj = 0; bj < 2; ++bj)
#pragma unroll
            for (int n = 0; n < 2; ++n) gg[bj][n] = *(const f32x4*)(gn + cb0 + bj * HALF + 4 * n);
#pragma unroll
        for (int ai = 0; ai < 2; ++ai)
#pragma unroll
            for (int m = 0; m < 4; ++m) { const int row = u.pm * BM + ai * HALF + wr * 64 + m * 16 + fr; const int b = row >> 13, s = row & (SEQ - 1);
                const float s1 = (float)((double)stats[(size_t)((b * NH + h) * 2 + 0) * SEQ + s] * (1.0 / 16777216.0)), s2 = (float)((double)stats[(size_t)((b * NH + h) * 2 + 1) * SEQ + s] * (1.0 / 16777216.0));
                const float mu = s1 * (1.0f / DV), var = s2 * (1.0f / DV) - mu * mu, rstd = 1.0f / sqrtf(fmaxf(var, 0.f) + EPS);
#pragma unroll
                for (int bj = 0; bj < 2; ++bj) { const u32x4 ow = *(const u32x4*)(O + (size_t)row * VTOT + cb0 + bj * HALF);
                    float o[8]; o[0] = __builtin_bit_cast(float, ow.x << 16); o[1] = __builtin_bit_cast(float, ow.x & 0xffff0000u); o[2] = __builtin_bit_cast(float, ow.y << 16); o[3] = __builtin_bit_cast(float, ow.y & 0xffff0000u);
                    o[4] = __builtin_bit_cast(float, ow.z << 16); o[5] = __builtin_bit_cast(float, ow.z & 0xffff0000u); o[6] = __builtin_bit_cast(float, ow.w << 16); o[7] = __builtin_bit_cast(float, ow.w & 0xffff0000u);
                    float y[8];
#pragma unroll
                    for (int n = 0; n < 2; ++n)
#pragma unroll
                        for (int e = 0; e < 4; ++e) { const float g = acc[ai][bj][m][n][e]; y[4 * n + e] = (o[4 * n + e] - mu) * rstd * gg[bj][n][e] * (g * sigmoidf_(g)); }
                    u32x4 w; w.x = cvt_pk_bf16(y[0], y[1]); w.y = cvt_pk_bf16(y[2], y[3]); w.z = cvt_pk_bf16(y[4], y[5]); w.w = cvt_pk_bf16(y[6], y[7]);
                    *(u32x4*)(Y + (size_t)row * VTOT + cb0 + bj * HALF) = w; } }
    }
};

template <class Epi, bool ALIGN_EPI = true, bool SP2 = true>
__device__ __forceinline__ void gemm_phase(LAS unsigned char* lds, LAS unsigned char* xl, const Gemm g, const StaticOrder& S, const Epi& E) {
    const int tid = threadIdx.x, wid = __builtin_amdgcn_readfirstlane(tid >> 6), lane = tid & 63, wr = wid >> 2, wc = wid & 3, fr = lane & 15, fq = lane >> 4;
    const int K = g.K, nt = K / BK, lda = g.lda;
    unsigned voffA[2], voffB[2];
#pragma unroll
    for (int i = 0; i < 2; ++i) { int R, C; stage_rc(tid * 16 + i * 8192, R, C); const int Rb = Epi::PERM ? ((R & ~31) + perm32(R & 31)) : R;
        voffA[i] = (unsigned)(R * lda + C) * 2u; voffB[i] = (unsigned)(Rb * K + C) * 2u; }
    const size_t kstep = (size_t)(BK * 2);
    const size_t hstepA = (size_t)HALF * lda * 2, hstepB = (size_t)HALF * K * 2;
    const size_t tstepA = 2 * hstepA, tstepB = 2 * hstepB;
    const unsigned ldsw = (unsigned)wid * 1024u;
    const int aoff = lds_byte(wr * 64 + fr, fq * 8), boff = lds_byte(wc * 32 + fr, fq * 8);
#define PG8_SA(b, h) (((b) * 2 + (h)) * HTB)
#define PG8_SB(b, h) ((4 + (b) * 2 + (h)) * HTB)
#define PG8_STAGE(bufoff, gbase, voff) do { _Pragma("unroll") for (int _i = 0; _i < 2; ++_i) \
        __builtin_amdgcn_global_load_lds((const unsigned*)((const char*)(gbase) + (voff)[_i]), (LAS unsigned*)(lds + (bufoff) + ldsw + _i * 8192), 16, 0, 0); } while (0)
#define PG8_LDA(dst, b, h) do { _Pragma("unroll") for (int m = 0; m < 4; ++m) _Pragma("unroll") for (int k = 0; k < 2; ++k) dst[m][k] = *(const LAS bf16x8*)(lds + PG8_SA(b, h) + aoff + m * 2048 + k * 1024); } while (0)
#define PG8_LDB(dst, b, h) do { _Pragma("unroll") for (int n = 0; n < 2; ++n) _Pragma("unroll") for (int k = 0; k < 2; ++k) dst[n][k] = *(const LAS bf16x8*)(lds + PG8_SB(b, h) + boff + n * 2048 + k * 1024); } while (0)
#define PG8_MMA(ai, bj, At, Bt) do { __builtin_amdgcn_s_setprio(1); _Pragma("unroll") for (int m = 0; m < 4; ++m) _Pragma("unroll") for (int n = 0; n < 2; ++n) _Pragma("unroll") for (int k = 0; k < 2; ++k) \
        acc[ai][bj][m][n] = __builtin_amdgcn_mfma_f32_16x16x32_bf16(Bt[n][k], At[m][k], acc[ai][bj][m][n], 0, 0, 0); __builtin_amdgcn_s_setprio(0); } while (0)
#define PG8_WAIT_V(n) asm volatile("s_waitcnt vmcnt(" #n ")" ::: "memory")
#define PG8_WAIT_L(n) asm volatile("s_waitcnt lgkmcnt(" #n ")" ::: "memory")
#define PG8_BAR __builtin_amdgcn_s_barrier()
#define PG8_SCHED __builtin_amdgcn_sched_barrier(0)
    Unit cur, nxt; int ui = 0;
    if (!S.next(0, cur)) return;
    Acc acc;
#pragma unroll
    for (int a = 0; a < 2; ++a)
#pragma unroll
        for (int b = 0; b < 2; ++b)
#pragma unroll
            for (int m = 0; m < 4; ++m)
#pragma unroll
                for (int n = 0; n < 2; ++n) acc[a][b][m][n] = (f32x4){0.f, 0.f, 0.f, 0.f};
    bf16x8 At[4][2], B0[2][2], B1[2][2];
    const char* cA = (const char*)g.A + (size_t)cur.pm * tstepA + (size_t)cur.pn * g.apn * 2; const char* cB = (const char*)g.Bt + (size_t)cur.pn * tstepB;
    if constexpr (SP2) {
        PG8_STAGE(PG8_SB(0, 0), cB, voffB); PG8_STAGE(PG8_SB(0, 1), cB + hstepB, voffB); PG8_STAGE(PG8_SA(0, 0), cA, voffA); PG8_STAGE(PG8_SA(0, 1), cA + hstepA, voffA);
        if (wr == 1) PG8_BAR;
        PG8_WAIT_V(2); PG8_BAR;
        PG8_STAGE(PG8_SB(1, 0), cB + kstep, voffB); PG8_STAGE(PG8_SA(1, 0), cA + kstep, voffA); PG8_STAGE(PG8_SB(1, 1), cB + hstepB + kstep, voffB);
        PG8_WAIT_V(6); PG8_BAR;
    } else {
        PG8_STAGE(PG8_SB(0, 0), cB, voffB); PG8_STAGE(PG8_SA(0, 0), cA, voffA); PG8_STAGE(PG8_SB(0, 1), cB + hstepB, voffB); PG8_STAGE(PG8_SA(0, 1), cA + hstepA, voffA);
        if (wr == 1) PG8_BAR;
        PG8_WAIT_V(4); PG8_BAR;
        PG8_STAGE(PG8_SB(1, 0), cB + kstep, voffB); PG8_STAGE(PG8_SA(1, 0), cA + kstep, voffA); PG8_STAGE(PG8_SB(1, 1), cB + hstepB + kstep, voffB);
        PG8_WAIT_V(6); PG8_BAR;
    }
    for (;;) {
        const bool has_next = S.next(ui + 1, nxt);
        const char* nA = has_next ? (const char*)g.A + (size_t)nxt.pm * tstepA + (size_t)nxt.pn * g.apn * 2 : cA; const char* nB = has_next ? (const char*)g.Bt + (size_t)nxt.pn * tstepB : cB;
        for (int t = 0; t < nt; t += 2) {
            const bool last = (t == nt - 2);
            const char* a1 = cA + (size_t)(t + 1) * kstep;
            const char* a2 = last ? nA : cA + (size_t)(t + 2) * kstep; const char* b2 = last ? nB : cB + (size_t)(t + 2) * kstep;
            const char* a3 = a2 + kstep; const char* b3 = b2 + kstep;
            if constexpr (SP2) {
            PG8_LDB(B0, 0, 0); PG8_LDB(B1, 0, 1); PG8_SCHED; PG8_LDA(At, 0, 0); PG8_STAGE(PG8_SA(1, 1), a1 + hstepA, voffA);
            PG8_WAIT_V(8); PG8_WAIT_L(0); PG8_BAR; PG8_MMA(0, 0, At, B0); PG8_MMA(0, 1, At, B1); PG8_BAR; PG8_SCHED;
            PG8_LDA(At, 0, 1); PG8_STAGE(PG8_SB(0, 0), b2, voffB); PG8_STAGE(PG8_SB(0, 1), b2 + hstepB, voffB); PG8_STAGE(PG8_SA(0, 0), a2, voffA);
            PG8_WAIT_V(8); PG8_WAIT_L(0); PG8_BAR; PG8_MMA(1, 0, At, B0); PG8_MMA(1, 1, At, B1); PG8_BAR; PG8_SCHED;
            PG8_LDB(B0, 1, 0); PG8_LDB(B1, 1, 1); PG8_SCHED; PG8_LDA(At, 1, 0); PG8_STAGE(PG8_SA(0, 1), a2 + hstepA, voffA);
            PG8_WAIT_V(8); PG8_WAIT_L(0); PG8_BAR; PG8_MMA(0, 0, At, B0); PG8_MMA(0, 1, At, B1); PG8_BAR; PG8_SCHED;
            PG8_LDA(At, 1, 1); PG8_STAGE(PG8_SB(1, 0), b3, voffB); PG8_STAGE(PG8_SB(1, 1), b3 + hstepB, voffB); PG8_STAGE(PG8_SA(1, 0), a3, voffA);
            PG8_WAIT_V(8); PG8_WAIT_L(0); PG8_BAR; PG8_MMA(1, 0, At, B0); PG8_MMA(1, 1, At, B1); PG8_BAR; PG8_SCHED;
            } else {
            PG8_LDB(B0, 0, 0); PG8_SCHED; PG8_LDA(At, 0, 0); PG8_STAGE(PG8_SA(1, 1), a1 + hstepA, voffA);
            PG8_WAIT_L(8); PG8_BAR; PG8_WAIT_L(0); PG8_MMA(0, 0, At, B0); PG8_BAR; PG8_SCHED;
            PG8_LDB(B1, 0, 1); PG8_STAGE(PG8_SB(0, 0), b2, voffB);
            PG8_BAR; PG8_WAIT_L(0); PG8_MMA(0, 1, At, B1); PG8_BAR;
            PG8_LDA(At, 0, 1); PG8_STAGE(PG8_SA(0, 0), a2, voffA);
            PG8_BAR; PG8_WAIT_L(0); PG8_MMA(1, 0, At, B0); PG8_BAR; PG8_SCHED;
            PG8_STAGE(PG8_SB(0, 1), b2 + hstepB, voffB);
            PG8_WAIT_V(6); PG8_BAR; PG8_MMA(1, 1, At, B1); PG8_BAR;
            PG8_LDB(B0, 1, 0); PG8_SCHED; PG8_LDA(At, 1, 0); PG8_STAGE(PG8_SA(0, 1), a2 + hstepA, voffA);
            PG8_WAIT_L(8); PG8_BAR; PG8_WAIT_L(0); PG8_MMA(0, 0, At, B0); PG8_BAR; PG8_SCHED;
            PG8_LDB(B1, 1, 1); PG8_STAGE(PG8_SB(1, 0), b3, voffB);
            PG8_BAR; PG8_WAIT_L(0); PG8_MMA(0, 1, At, B1); PG8_BAR;
            PG8_LDA(At, 1, 1); PG8_STAGE(PG8_SA(1, 0), a3, voffA);
            PG8_BAR; PG8_WAIT_L(0); PG8_MMA(1, 0, At, B0); PG8_BAR; PG8_SCHED;
            PG8_STAGE(PG8_SB(1, 1), b3 + hstepB, voffB);
            PG8_WAIT_V(6); PG8_BAR; PG8_MMA(1, 1, At, B1); PG8_BAR;
            }
        }
        if constexpr (ALIGN_EPI) { if (wr == 0) PG8_BAR; }
        E(acc, cur, wr, wc, fr, fq, xl, wid, lane);
        if (!has_next) break;
#pragma unroll
        for (int a = 0; a < 2; ++a)
#pragma unroll
            for (int b = 0; b < 2; ++b)
#pragma unroll
                for (int m = 0; m < 4; ++m)
#pragma unroll
                    for (int n = 0; n < 2; ++n) acc[a][b][m][n] = (f32x4){0.f, 0.f, 0.f, 0.f};
        cur = nxt; cA = nA; cB = nB; ++ui;
        if constexpr (ALIGN_EPI) { if (wr == 1) PG8_BAR; }
    }
    PG8_WAIT_V(0);
    if constexpr (!ALIGN_EPI) { if (wr == 0) PG8_BAR; }
    PG8_BAR;
#undef PG8_SA
#undef PG8_SB
#undef PG8_STAGE
#undef PG8_LDA
#undef PG8_LDB
#undef PG8_MMA
#undef PG8_WAIT_V
#undef PG8_WAIT_L
#undef PG8_BAR
#undef PG8_SCHED
}
}

constexpr size_t MiB = 1u << 20;
constexpr size_t WS_CTL = 0, WS_STATS = 1 * MiB, CTL_ZERO_BYTES = 3 * MiB;
constexpr size_t WS_WIN = 3 * MiB, WS_WOUT = 15 * MiB;
constexpr size_t WS_HN = 19 * MiB;
constexpr size_t WS_DIFF = 83 * MiB;
constexpr size_t WS_FA = 147 * MiB, WS_FB = 352 * MiB, WS_FC = 275 * MiB;
constexpr size_t WS_ACT = 147 * MiB, WS_HALO = 323 * MiB;
constexpr size_t WS_WPOOL = 334 * MiB, WS_WUP0 = 335 * MiB, WS_WDN0 = 346 * MiB;
constexpr size_t WS_Q = 83 * MiB, WS_KT = 147 * MiB, WS_VT = 211 * MiB, WS_P = 339 * MiB, WS_K = 371 * MiB, WS_O = 371 * MiB;
constexpr size_t WS_WUP1 = 83 * MiB, WS_WDN1 = 94 * MiB;
constexpr size_t WS_Y = 147 * MiB;
constexpr size_t WS_END = 512 * MiB;

constexpr int RING_BYTES = 131072, XL_OFF = RING_BYTES, XL_BYTES = 8192 + 8 * 2304, MISC_OFF = XL_OFF + XL_BYTES;
constexpr int LDS_BYTES = 163840 - 4096;
static_assert(MISC_OFF + 256 <= LDS_BYTES, "LDS map");
constexpr int NWAVES = 8;

typedef GAS unsigned gu32;
#define RLX_AGENT __ATOMIC_RELAXED, __HIP_MEMORY_SCOPE_AGENT
#define XB_TMO      128
#define XB_XCNT(j)  (256  + 64 * (j))
#define XB_XSUB(j)  (1280 + 64 * (j))
#define XB_XGEN(j)  (2304 + 64 * (j))
#define XB_TOP      3328
#define XB_TOPGEN   3392
#define XCD_BAR_WORDS 3456
#define XB_SPIN_CAP (1u << 18)
__device__ __forceinline__ unsigned xb_ld(unsigned* p)              { return __hip_atomic_load(p, __ATOMIC_RELAXED, __HIP_MEMORY_SCOPE_AGENT); }
__device__ __forceinline__ unsigned xb_add(unsigned* p, unsigned v) { return __hip_atomic_fetch_add(p, v, __ATOMIC_RELAXED, __HIP_MEMORY_SCOPE_AGENT); }
__device__ __forceinline__ unsigned xb_xcc_id() { return (unsigned)__builtin_amdgcn_s_getreg((3 << 11) | 20) & 0xFu; }
#define XB_SPIN(cond, bar) do { unsigned _sp = 0; while (cond) { __builtin_amdgcn_s_sleep(1); \
    if ((++_sp & 255u) == 0u) { if (xb_ld(&(bar)[XB_TMO])) break; if (_sp > XB_SPIN_CAP) { atomicAdd(&(bar)[XB_TMO], 1u); break; } } } } while (0)
struct XcdBarrier { unsigned* bar; unsigned x; volatile LAS unsigned* st; };
__device__ __forceinline__ XcdBarrier xcd_barrier_post(unsigned* bar, volatile LAS unsigned* st) {
    XcdBarrier b; b.bar = bar; b.x = xb_xcc_id(); b.st = st;
    if (threadIdx.x == 0) (void)xb_add(&bar[XB_XCNT(b.x)], 1u);
    return b;
}
__device__ __forceinline__ void xcd_barrier_complete(unsigned* bar, unsigned x, unsigned& nloc, unsigned& nx) {
    const unsigned G = gridDim.x * gridDim.y * gridDim.z;
    unsigned sum, cnt, mine, sp = 0u;
    for (;;) {
        sum = 0u; cnt = 0u; mine = 0u;
#pragma unroll
        for (unsigned j = 0; j < 16; ++j) { const unsigned c = xb_ld(&bar[XB_XCNT(j)]); sum += c; cnt += (c > 0u) ? 1u : 0u; mine = (j == x) ? c : mine; }
        if (sum == G) break;
        __builtin_amdgcn_s_sleep(1);
        if ((++sp & 255u) == 0u) { if (xb_ld(&bar[XB_TMO])) break; if (sp > XB_SPIN_CAP) { atomicAdd(&bar[XB_TMO], 1u); break; } }
    }
    nloc = mine > 0u ? mine : 1u; nx = cnt > 0u ? cnt : 1u;
}
__device__ __forceinline__ void xcd_barrier(const XcdBarrier& b) {
    asm volatile("s_waitcnt vmcnt(0)" ::: "memory");
    __syncthreads();
    if (threadIdx.x == 0) {
        unsigned* bar = b.bar;
        __builtin_amdgcn_s_waitcnt(0);
        unsigned nloc = b.st[0], nx = b.st[1];
        if (nloc == 0u) { xcd_barrier_complete(bar, b.x, nloc, nx); b.st[0] = nloc; b.st[1] = nx; }
        const unsigned old = xb_add(&bar[XB_XSUB(b.x)], 1u);
        const unsigned gen = old / nloc;
        if (old + 1u == (gen + 1u) * nloc) {
            __builtin_amdgcn_fence(__ATOMIC_RELEASE, "agent");
            asm volatile("s_waitcnt vmcnt(0)" ::: "memory");
            const unsigned og = xb_add(&bar[XB_TOP], 1u);
            const unsigned tg = og / nx;
            if (og + 1u == (tg + 1u) * nx) xb_add(&bar[XB_TOPGEN], 1u);
            else XB_SPIN(xb_ld(&bar[XB_TOPGEN]) == tg, bar);
            __builtin_amdgcn_fence(__ATOMIC_ACQUIRE, "agent");
            xb_add(&bar[XB_XGEN(b.x)], 1u);
            asm volatile("s_waitcnt vmcnt(0)" ::: "memory");
        } else {
            XB_SPIN(xb_ld(&bar[XB_XGEN(b.x)]) == gen, bar);
            __builtin_amdgcn_fence(__ATOMIC_ACQUIRE, "agent");
            asm volatile("s_waitcnt vmcnt(0)" ::: "memory");
        }
    }
    __syncthreads();
}
constexpr int CW_BAR = 4096;

struct Frame {
    LAS unsigned char* lds;
    int tid, lane, wave, G;
    const float* in[12]; float* out; unsigned char* ws;
};

__device__ __forceinline__ float wave_sum(float v) {
#pragma unroll
    for (int o = 1; o < 64; o <<= 1) v += __shfl_xor(v, o);
    return v;
}

__device__ __forceinline__ void transpose_item(const float* W, int K, int N, bf16_t* WT, int k0, int n0, int drow0, LAS float* scr, int lane) {
#pragma unroll 8
    for (int i = 0; i < 32; ++i) { const int kk = 2 * i + (lane >> 5); scr[kk * 33 + (lane & 31)] = W[(size_t)(k0 + kk) * N + n0 + (lane & 31)]; }
    asm volatile("s_waitcnt lgkmcnt(0)" ::: "memory");
    const int c = lane & 7;
#pragma unroll
    for (int j = 0; j < 4; ++j) { const int n = (lane >> 3) + 8 * j; const LAS float* s = scr + (8 * c) * 33 + n;
        u32x4 o; o.x = f2bf(s[0 * 33]) | (f2bf(s[1 * 33]) << 16); o.y = f2bf(s[2 * 33]) | (f2bf(s[3 * 33]) << 16); o.z = f2bf(s[4 * 33]) | (f2bf(s[5 * 33]) << 16); o.w = f2bf(s[6 * 33]) | (f2bf(s[7 * 33]) << 16);
        *(u32x4*)(WT + (size_t)(drow0 + n) * K + k0 + 8 * c) = o; }
    asm volatile("s_waitcnt lgkmcnt(0)" ::: "memory");
}
__device__ __forceinline__ int upmap(int n0) { return n0 < FF ? 256 * (n0 >> 7) + (n0 & 127) : 256 * ((n0 - FF) >> 7) + 128 + ((n0 - FF) & 127); }
__device__ __forceinline__ void transpose_plain(Frame& F, const float* W, int K, int N, bf16_t* WT, int it) {
    LAS float* scr = (LAS float*)(F.lds + F.wave * 16384); const int nblk = N / 32, kb = it / nblk, nb = it % nblk;
    transpose_item(W, K, N, WT, 64 * kb, 32 * nb, 32 * nb, scr, F.lane);
}
__device__ __forceinline__ void transpose_up(Frame& F, const float* W, bf16_t* WT, int it) {
    LAS float* scr = (LAS float*)(F.lds + F.wave * 16384); const int nblk = FF2 / 32, kb = it / nblk, nb = it % nblk;
    transpose_item(W, D, FF2, WT, 64 * kb, 32 * nb, upmap(32 * nb), scr, F.lane);
}

__device__ __forceinline__ void pool_diff_unit(Frame& F, int unit, const float* x, const float* gain, bf16_t* DIFF) {
    LAS float* rs = (LAS float*)(F.lds + 8 * 16384);
    const int t0 = unit * 64, ts0 = t0 & ~(SEQ - 1);
    for (int r = F.wave; r < 80; r += NWAVES) { const int t = t0 - 16 + r; float rstd = 0.f;
        if (t >= ts0) { const f32x4* xr = (const f32x4*)(x + (size_t)t * D) + F.lane; float s = 0.f;
#pragma unroll
            for (int j = 0; j < 4; ++j) { const f32x4 v = xr[64 * j]; s += (v.x * v.x + v.y * v.y) + (v.z * v.z + v.w * v.w); }
            rstd = 1.0f / sqrtf(wave_sum(s) * (1.0f / D) + EPS); }
        if (F.lane == 0) rs[r] = rstd; }
    __syncthreads();
    const int c0 = 2 * F.tid, win = 2 << (c0 >> 8);
    const f32x2 gv = *(const f32x2*)(gain + c0);
    f32x2 ring[16];
#pragma unroll
    for (int i = 0; i < 16; ++i) ring[i] = (f32x2){0.f, 0.f};
    for (int rb = 0; rb < 80; rb += 16) {
#pragma unroll
        for (int ri = 0; ri < 16; ++ri) { const int r = rb + ri, t = t0 - 16 + r;
            f32x2 h = (f32x2){0.f, 0.f};
            if (t >= ts0) { const f32x2 xv = *(const f32x2*)(x + (size_t)t * D + c0); const float rr = rs[r]; h.x = xv.x * rr * gv.x; h.y = xv.y * rr * gv.y; }
            ring[ri] = h;
            if (rb >= 16) { f32x2 s = (f32x2){0.f, 0.f};
#pragma unroll
                for (int k = 0; k < 16; ++k) if (k < win) { s.x += ring[(ri - k) & 15].x; s.y += ring[(ri - k) & 15].y; }
                const int cnt = min(t - ts0 + 1, win); const float ic = 1.0f / (float)cnt;
                *(unsigned*)(DIFF + (size_t)t * D + c0) = cvt_pk_bf16(s.x * ic - h.x, s.y * ic - h.y); } }
    }
    __syncthreads();
}

__device__ __forceinline__ void resnorm_phase(Frame& F, const float* f, const float* pscale, const float* base, float* out, const float* ga, const float* gb, bf16_t* hn) {
    const int gw = blockIdx.x * NWAVES + F.wave, NGW = F.G * NWAVES;
    f32x4 a4[4], b4[4], p4[4];
#pragma unroll
    for (int j = 0; j < 4; ++j) { a4[j] = *((const f32x4*)ga + F.lane + 64 * j); b4[j] = gb ? *((const f32x4*)gb + F.lane + 64 * j) : (f32x4){0.f, 0.f, 0.f, 0.f}; p4[j] = pscale ? *((const f32x4*)pscale + F.lane + 64 * j) : (f32x4){1.f, 1.f, 1.f, 1.f}; }
    for (int row = gw; row < M; row += NGW) {
        const f32x4* fr = (const f32x4*)(f + (size_t)row * D) + F.lane; const f32x4* br = (const f32x4*)(base + (size_t)row * D) + F.lane;
        f32x4 v[4], x[4]; float s = 0.f;
#pragma unroll
        for (int j = 0; j < 4; ++j) { v[j] = fr[64 * j] * p4[j]; x[j] = br[64 * j]; s += (v[j].x * v[j].x + v[j].y * v[j].y) + (v[j].z * v[j].z + v[j].w * v[j].w); }
        const float r = 1.0f / sqrtf(wave_sum(s) * (1.0f / D) + EPS); float s2 = 0.f;
#pragma unroll
        for (int j = 0; j < 4; ++j) { x[j] = x[j] + v[j] * r * a4[j]; s2 += (x[j].x * x[j].x + x[j].y * x[j].y) + (x[j].z * x[j].z + x[j].w * x[j].w); *((f32x4*)(out + (size_t)row * D) + F.lane + 64 * j) = x[j]; }
        if (hn) { const float r2 = 1.0f / sqrtf(wave_sum(s2) * (1.0f / D) + EPS);
#pragma unroll
            for (int j = 0; j < 4; ++j) { const f32x4 o = x[j] * r2 * b4[j]; u32x2 w; w.x = cvt_pk_bf16(o.x, o.y); w.y = cvt_pk_bf16(o.z, o.w); *((u32x2*)(hn + (size_t)row * D) + F.lane + 64 * j) = w; } }
    }
}

__device__ __forceinline__ void convfix_phase(Frame& F, const float* halo, const float* cw, const float* cb, bf16_t* act) {
    const int total = (M / 256) * 2 * FF;
    for (int i = blockIdx.x * 512 + F.tid; i < total; i += F.G * 512) {
        const int pm = i / (2 * FF), rem = i - pm * 2 * FF, rho = rem / FF, j = rem - rho * FF;
        const bool first = (pm & 31) == 0;
        float cg = cb[j], cv = cb[FF + j];
#pragma unroll
        for (int t = 0; t < 3; ++t) { const int r = rho - 2 + t; float ug = 0.f, uv = 0.f;
            if (r >= 0) { ug = halo[(size_t)(pm * 4 + r) * FF2 + j]; uv = halo[(size_t)(pm * 4 + r) * FF2 + FF + j]; }
            else if (!first) { ug = halo[(size_t)((pm - 1) * 4 + 4 + r) * FF2 + j]; uv = halo[(size_t)((pm - 1) * 4 + 4 + r) * FF2 + FF + j]; }
            cg += cw[t * FF2 + j] * ug; cv += cw[t * FF2 + FF + j] * uv; }
        act[(size_t)(pm * 256 + rho) * FF + j] = (bf16_t)f2bf(cg * sigmoidf_(cg) * cv);
    }
}

__device__ __forceinline__ void scores_phase(Frame& F, const bf16_t* Q, const bf16_t* Kr, bf16_t* P) {
    const int l15 = F.lane & 15, lq = F.lane >> 4, w = F.wave;
    for (int u = blockIdx.x; u < BATCH * NH * NCH; u += F.G) {
        const int b = u >> 8, h = (u >> 6) & 3, n = u & 63; const size_t t0 = (size_t)b * SEQ + 128 * n; const float l2g = l2gamma(h);
        bf16x8 qf[8];
#pragma unroll
        for (int ks = 0; ks < 8; ++ks) qf[ks] = *(const bf16x8*)(Q + (t0 + 16 * w + l15) * D + 256 * h + 32 * ks + 8 * lq);
        bf16_t* prow = P + ((size_t)u * 128 + 16 * w + l15) * 128 + 4 * lq;
        for (int jt = 0; jt < 8; ++jt) {
            u32x2 o; o.x = 0u; o.y = 0u;
            if (jt <= w) { f32x4 acc = (f32x4){0.f, 0.f, 0.f, 0.f};
#pragma unroll
                for (int ks = 0; ks < 8; ++ks) { const bf16x8 kf = *(const bf16x8*)(Kr + (t0 + 16 * jt + l15) * D + 256 * h + 32 * ks + 8 * lq); acc = __builtin_amdgcn_mfma_f32_16x16x32_bf16(kf, qf[ks], acc, 0, 0, 0); }
                float v[4];
#pragma unroll
                for (int r = 0; r < 4; ++r) { const int dij = (16 * w + l15) - (16 * jt + 4 * lq + r); v[r] = dij >= 0 ? acc[r] * __builtin_amdgcn_exp2f((float)dij * l2g) : 0.f; }
                o.x = cvt_pk_bf16(v[0], v[1]); o.y = cvt_pk_bf16(v[2], v[3]); }
            *(u32x2*)(prow + 16 * jt) = o;
        }
    }
}

__device__ __forceinline__ void scan_phase(Frame& F, const bf16_t* Q, const bf16_t* P, const bf16_t* KT, const bf16_t* VT, bf16_t* O, unsigned long long* stats) {
    const int l15 = F.lane & 15, lq = F.lane >> 4, w = F.wave;
    LAS unsigned char* ST = F.lds;
    for (int uidx = blockIdx.x; uidx < 256; uidx += F.G) {
        const int x8 = uidx & 7, li = uidx >> 3, p = 2 * x8 + (li >> 4), slice = li & 15, b = p >> 2, h = p & 3;
        const float l2g = l2gamma(h), cdk = __builtin_amdgcn_exp2f(128.0f * l2g), crd = __builtin_amdgcn_exp2f((float)(16 * w + l15 + 1) * l2g);
        f32x4 as[2][2];
#pragma unroll
        for (int a = 0; a < 2; ++a)
#pragma unroll
            for (int c = 0; c < 2; ++c) as[a][c] = (f32x4){0.f, 0.f, 0.f, 0.f};
        for (int i = F.tid; i < 32 * 528 / 16; i += 512) ((LAS u32x4*)ST)[i] = (u32x4){0u, 0u, 0u, 0u};
        __syncthreads();
        const size_t tb0 = (size_t)b * SEQ;
        const bf16_t* qrow = Q + (tb0 + 16 * w + l15) * D + 256 * h + 8 * lq;
        const bf16_t* prow = P + ((size_t)((b * NH + h) * NCH) * 128 + 16 * w + l15) * 128 + 8 * lq;
        const bf16_t* vrow0 = VT + (size_t)(DV * h + 32 * slice + l15) * M + tb0 + 8 * lq;
        const bf16_t* krow0 = KT + (size_t)(DK * h + 32 * w + l15) * M + tb0 + 8 * lq;
        bf16_t* orow = O + (tb0 + 16 * w + l15) * VTOT + DV * h + 32 * slice + 4 * lq;
        unsigned long long* st1 = stats + (size_t)((b * NH + h) * 2) * SEQ + 16 * w + l15;
        for (int n = 0; n < NCH; ++n) {
            bf16x8 qf[8], pf[4], vf[2][4], kf[2][4];
#pragma unroll
            for (int ks = 0; ks < 8; ++ks) qf[ks] = *(const bf16x8*)(qrow + (size_t)n * 128 * D + 32 * ks);
#pragma unroll
            for (int ks = 0; ks < 4; ++ks) pf[ks] = *(const bf16x8*)(prow + (size_t)n * 128 * 128 + 32 * ks);
#pragma unroll
            for (int vt = 0; vt < 2; ++vt)
#pragma unroll
                for (int ks = 0; ks < 4; ++ks) vf[vt][ks] = *(const bf16x8*)(vrow0 + (size_t)(16 * vt) * M + n * 128 + 32 * ks);
#pragma unroll
            for (int dt = 0; dt < 2; ++dt)
#pragma unroll
                for (int ks = 0; ks < 4; ++ks) kf[dt][ks] = *(const bf16x8*)(krow0 + (size_t)(16 * dt) * M + n * 128 + 32 * ks);
            f32x4 ao[2]; ao[0] = (f32x4){0.f, 0.f, 0.f, 0.f}; ao[1] = ao[0];
#pragma unroll
            for (int ks = 0; ks < 8; ++ks)
#pragma unroll
                for (int vt = 0; vt < 2; ++vt) { const bf16x8 sx = *(const LAS bf16x8*)(ST + (16 * vt + l15) * 528 + (32 * ks + 8 * lq) * 2); ao[vt] = __builtin_amdgcn_mfma_f32_16x16x32_bf16(sx, qf[ks], ao[vt], 0, 0, 0); }
            ao[0] = ao[0] * crd; ao[1] = ao[1] * crd;
#pragma unroll
            for (int ks = 0; ks < 4; ++ks)
#pragma unroll
                for (int vt = 0; vt < 2; ++vt) ao[vt] = __builtin_amdgcn_mfma_f32_16x16x32_bf16(vf[vt][ks], pf[ks], ao[vt], 0, 0, 0);
            float s1 = 0.f, s2 = 0.f;
#pragma unroll
            for (int vt = 0; vt < 2; ++vt) { u32x2 o; o.x = cvt_pk_bf16(ao[vt][0], ao[vt][1]); o.y = cvt_pk_bf16(ao[vt][2], ao[vt][3]); *(u32x2*)(orow + (size_t)n * 128 * VTOT + 16 * vt) = o;
#pragma unroll
                for (int r = 0; r < 4; ++r) { s1 += ao[vt][r]; s2 += ao[vt][r] * ao[vt][r]; } }
            s1 += __shfl_xor(s1, 16); s1 += __shfl_xor(s1, 32); s2 += __shfl_xor(s2, 16); s2 += __shfl_xor(s2, 32);
            if (lq == 0) { atomicAdd(st1 + n * 128, (unsigned long long)__float2ll_rn(s1 * 16777216.0f)); atomicAdd(st1 + SEQ + n * 128, (unsigned long long)__float2ll_rn(s2 * 16777216.0f)); }
#pragma unroll
            for (int dt = 0; dt < 2; ++dt)
#pragma unroll
                for (int vt = 0; vt < 2; ++vt) as[dt][vt] = as[dt][vt] * cdk;
#pragma unroll
            for (int ks = 0; ks < 4; ++ks)
#pragma unroll
                for (int dt = 0; dt < 2; ++dt)
#pragma unroll
                    for (int vt = 0; vt < 2; ++vt) as[dt][vt] = __builtin_amdgcn_mfma_f32_16x16x32_bf16(kf[dt][ks], vf[vt][ks], as[dt][vt], 0, 0, 0);
            __syncthreads();
#pragma unroll
            for (int dt = 0; dt < 2; ++dt)
#pragma unroll
                for (int vt = 0; vt < 2; ++vt) { u32x2 o; o.x = cvt_pk_bf16(as[dt][vt][0], as[dt][vt][1]); o.y = cvt_pk_bf16(as[dt][vt][2], as[dt][vt][3]);
                    *(LAS u32x2*)(ST + (16 * vt + l15) * 528 + (32 * w + 16 * dt + 4 * lq) * 2) = o; }
            __syncthreads();
        }
    }
}

struct Args { const float* in[12]; float* out; unsigned char* ws; int ph_lo, ph_hi; };
constexpr int N_PHASES = 17;

__global__ void __launch_bounds__(NWAVES * 64, 2) mk_fwd(Args args) {
    extern __shared__ __attribute__((aligned(16))) unsigned char lds_raw[];
    Frame F;
    F.lds = (LAS unsigned char*)lds_raw;
    F.tid = threadIdx.x; F.lane = F.tid & 63; F.wave = __builtin_amdgcn_readfirstlane(F.tid >> 6); F.G = gridDim.x;
#pragma unroll
    for (int i = 0; i < 12; ++i) F.in[i] = args.in[i];
    F.out = args.out; F.ws = args.ws;
    unsigned char* ws = args.ws;
    LAS unsigned char* xl = F.lds + XL_OFF;
    const float* x = F.in[0]; const int* pos = (const int*)F.in[1]; const float* ng = F.in[2];
    const float* pool_w = F.in[3]; const float* pool_scale = F.in[4]; const float* w_in = F.in[5]; const float* gn = F.in[6]; const float* w_out = F.in[7];
    const float* w_up = F.in[8]; const float* conv_w = F.in[9]; const float* conv_b = F.in[10]; const float* w_down = F.in[11];
    bf16_t* HN = (bf16_t*)(ws + WS_HN); float* XR = F.out;
    const int gwv = blockIdx.x * NWAVES + F.wave, NGW = F.G * NWAVES;
    const int lo = args.ph_lo, hi = args.ph_hi;
#define IN(k) (lo <= (k) && (k) < hi)
    volatile LAS unsigned* MISC = (volatile LAS unsigned*)(F.lds + MISC_OFF);
    if (F.tid < 64) MISC[F.tid] = 0u;
    __syncthreads();
    XcdBarrier bar; bar.bar = (unsigned*)(ws + WS_CTL) + CW_BAR; bar.x = 0; bar.st = nullptr;
    if (hi - lo > 1) bar = xcd_barrier_post((unsigned*)(ws + WS_CTL) + CW_BAR, MISC + 8);
#define SEAM(k) do { if (IN(k) && IN((k) + 1)) xcd_barrier(bar); } while (0)

    if (IN(0)) {
        constexpr int I_IN = (D / 64) * (RIN / 32), I_OUT = (VTOT / 64) * (D / 32), I_POOL = 4 * (256 / 64) * (256 / 32), I_UP = (D / 64) * (FF2 / 32), I_DN = (FF / 64) * (D / 32);
        constexpr int NIT = I_IN + I_OUT + I_POOL + I_UP + I_DN;
        for (int it = gwv; it < NIT; it += NGW) { int r = it;
            if (r < I_IN) { transpose_plain(F, w_in, D, RIN, (bf16_t*)(ws + WS_WIN), r); continue; } r -= I_IN;
            if (r < I_OUT) { transpose_plain(F, w_out, VTOT, D, (bf16_t*)(ws + WS_WOUT), r); continue; } r -= I_OUT;
            if (r < I_POOL) { const int g = r >> 5; transpose_plain(F, pool_w + (size_t)g * 65536, 256, 256, (bf16_t*)(ws + WS_WPOOL) + (size_t)g * 65536, r & 31); continue; } r -= I_POOL;
            if (r < I_UP) { transpose_up(F, w_up, (bf16_t*)(ws + WS_WUP0), r); continue; } r -= I_UP;
            transpose_plain(F, w_down, FF, D, (bf16_t*)(ws + WS_WDN0), r); }
        __syncthreads();
        for (int u = blockIdx.x; u < M / 64; u += F.G) pool_diff_unit(F, u, x, ng, (bf16_t*)(ws + WS_DIFF));
    }
    SEAM(0);
    if (IN(1)) {
        pg8::Gemm g{(const bf16_t*)(ws + WS_DIFF), (const bf16_t*)(ws + WS_WPOOL), M, D, 256, D, 256}; pg8::StaticOrder S; S.init(M, D, F.G, (int)blockIdx.x);
        pg8::EpiF32 E{(float*)(ws + WS_FA), D};
        pg8::gemm_phase<pg8::EpiF32>(F.lds, xl, g, S, E);
    }
    SEAM(1);
    if (IN(2)) resnorm_phase(F, (const float*)(ws + WS_FA), pool_scale, x, XR, ng + 1 * D, ng + 2 * D, HN);
    SEAM(2);
    if (IN(3)) {
        pg8::Gemm g{HN, (const bf16_t*)(ws + WS_WUP0), M, FF2, D, D, 0}; pg8::StaticOrder S; S.init(M, FF2, F.G, (int)blockIdx.x);
        pg8::EpiConvGlu E{(bf16_t*)(ws + WS_ACT), (float*)(ws + WS_HALO), conv_w, conv_b};
        pg8::gemm_phase<pg8::EpiConvGlu>(F.lds, xl, g, S, E);
    }
    SEAM(3);
    if (IN(4)) convfix_phase(F, (const float*)(ws + WS_HALO), conv_w, conv_b, (bf16_t*)(ws + WS_ACT));
    SEAM(4);
    if (IN(5)) {
        pg8::Gemm g{(const bf16_t*)(ws + WS_ACT), (const bf16_t*)(ws + WS_WDN0), M, D, FF, FF, 0}; pg8::StaticOrder S; S.init(M, D, F.G, (int)blockIdx.x);
        pg8::EpiF32 E{(float*)(ws + WS_FB), D};
        pg8::gemm_phase<pg8::EpiF32>(F.lds, xl, g, S, E);
    }
    SEAM(5);
    if (IN(6)) resnorm_phase(F, (const float*)(ws + WS_FB), nullptr, XR, XR, ng + 3 * D, ng + 4 * D, HN);
    SEAM(6);
    if (IN(7)) {
        pg8::Gemm g{HN, (const bf16_t*)(ws + WS_WIN), M, 4096, D, D, 0}; pg8::StaticOrder S; S.init(M, 4096, F.G, (int)blockIdx.x);
        pg8::EpiRetA E{(bf16_t*)(ws + WS_Q), (bf16_t*)(ws + WS_K), (bf16_t*)(ws + WS_KT), (bf16_t*)(ws + WS_VT), pos};
        pg8::gemm_phase<pg8::EpiRetA>(F.lds, xl, g, S, E);
    }
    SEAM(7);
    if (IN(8)) scores_phase(F, (const bf16_t*)(ws + WS_Q), (const bf16_t*)(ws + WS_K), (bf16_t*)(ws + WS_P));
    SEAM(8);
    if (IN(9)) scan_phase(F, (const bf16_t*)(ws + WS_Q), (const bf16_t*)(ws + WS_P), (const bf16_t*)(ws + WS_KT), (const bf16_t*)(ws + WS_VT), (bf16_t*)(ws + WS_O), (unsigned long long*)(ws + WS_STATS));
    SEAM(9);
    if (IN(10)) {
        constexpr int I_UP = (D / 64) * (FF2 / 32), I_DN = (FF / 64) * (D / 32);
        for (int it = gwv; it < I_UP + I_DN; it += NGW) {
            if (it < I_UP) transpose_up(F, w_up + (size_t)D * FF2, (bf16_t*)(ws + WS_WUP1), it);
            else transpose_plain(F, w_down + (size_t)FF * D, FF, D, (bf16_t*)(ws + WS_WDN1), it - I_UP); }
        __syncthreads();
        pg8::Gemm g{HN, (const bf16_t*)(ws + WS_WIN) + (size_t)4096 * D, M, VTOT, D, D, 0}; pg8::StaticOrder S; S.init(M, VTOT, F.G, (int)blockIdx.x);
        pg8::EpiRetB E{(const bf16_t*)(ws + WS_O), (const long long*)(ws + WS_STATS), gn, (bf16_t*)(ws + WS_Y)};
        pg8::gemm_phase<pg8::EpiRetB>(F.lds, xl, g, S, E);
    }
    SEAM(10);
    if (IN(11)) {
        pg8::Gemm g{(const bf16_t*)(ws + WS_Y), (const bf16_t*)(ws + WS_WOUT), M, D, VTOT, VTOT, 0}; pg8::StaticOrder S; S.init(M, D, F.G, (int)blockIdx.x);
        pg8::EpiF32 E{(float*)(ws + WS_FC), D};
        pg8::gemm_phase<pg8::EpiF32>(F.lds, xl, g, S, E);
    }
    SEAM(11);
    if (IN(12)) resnorm_phase(F, (const float*)(ws + WS_FC), nullptr, XR, XR, ng + 5 * D, ng + 6 * D, HN);
    SEAM(12);
    if (IN(13)) {
        pg8::Gemm g{HN, (const bf16_t*)(ws + WS_WUP1), M, FF2, D, D, 0}; pg8::StaticOrder S; S.init(M, FF2, F.G, (int)blockIdx.x);
        pg8::EpiConvGlu E{(bf16_t*)(ws + WS_ACT), (float*)(ws + WS_HALO), conv_w + 3 * FF2, conv_b + FF2};
        pg8::gemm_phase<pg8::EpiConvGlu>(F.lds, xl, g, S, E);
    }
    SEAM(13);
    if (IN(14)) convfix_phase(F, (const float*)(ws + WS_HALO), conv_w + 3 * FF2, conv_b + FF2, (bf16_t*)(ws + WS_ACT));
    SEAM(14);
    if (IN(15)) {
        pg8::Gemm g{(const bf16_t*)(ws + WS_ACT), (const bf16_t*)(ws + WS_WDN1), M, D, FF, FF, 0}; pg8::StaticOrder S; S.init(M, D, F.G, (int)blockIdx.x);
        pg8::EpiF32 E{(float*)(ws + WS_FB), D};
        pg8::gemm_phase<pg8::EpiF32>(F.lds, xl, g, S, E);
    }
    SEAM(15);
    if (IN(16)) resnorm_phase(F, (const float*)(ws + WS_FB), nullptr, XR, XR, ng + 7 * D, nullptr, nullptr);
#ifdef MK_DUMP
    if (IN(100)) { const bf16_t* b0 = (const bf16_t*)(ws + WS_Q); const bf16_t* b1 = (const bf16_t*)(ws + WS_K); const bf16_t* b2 = (const bf16_t*)(ws + WS_KT); const bf16_t* b3 = (const bf16_t*)(ws + WS_VT);
        for (size_t i = (size_t)blockIdx.x * 512 + F.tid; i < (size_t)M * D; i += (size_t)F.G * 512) XR[i] = bf2f(b0[i]) + bf2f(b1[i]) + bf2f(b2[i]) + bf2f(b3[i]) + bf2f(b3[(size_t)M * D + i]); }
    if (IN(101)) { const bf16_t* b0 = (const bf16_t*)(ws + WS_P);
        for (size_t i = (size_t)blockIdx.x * 512 + F.tid; i < (size_t)M * D; i += (size_t)F.G * 512) XR[i] = bf2f(b0[i & (16777216 - 1)]); }
    if (IN(102)) { const bf16_t* b0 = (const bf16_t*)(ws + WS_O); const long long* st = (const long long*)(ws + WS_STATS);
        for (size_t i = (size_t)blockIdx.x * 512 + F.tid; i < (size_t)M * D; i += (size_t)F.G * 512) XR[i] = bf2f(b0[i]) + bf2f(b0[(size_t)M * D + i]); }
    if (IN(103)) { const bf16_t* b0 = (const bf16_t*)(ws + WS_Y);
        for (size_t i = (size_t)blockIdx.x * 512 + F.tid; i < (size_t)M * D; i += (size_t)F.G * 512) XR[i] = bf2f(b0[i]) + bf2f(b0[(size_t)M * D + i]); }
#endif
#undef IN
}

extern "C" void kernel_launch(void* const* d_in, const int* in_sizes, int n_in, void* d_out, int out_size, void* d_ws, size_t ws_size, hipStream_t stream) {
    static int grid = 0;
    if (grid == 0) {
        if (n_in != 12 || in_sizes[0] != M * D || out_size != M * D || ws_size < WS_END) { fprintf(stderr, "kernel_launch: unexpected shapes (n_in %d, in0 %d, out %d, ws %zu)\n", n_in, n_in > 0 ? in_sizes[0] : -1, out_size, ws_size); grid = -1; return; }
        int dev = 0, cus = 0, per_cu = 0;
        if (hipGetDevice(&dev) != hipSuccess || hipDeviceGetAttribute(&cus, hipDeviceAttributeMultiprocessorCount, dev) != hipSuccess) { grid = -1; return; }
        if (hipFuncSetAttribute((const void*)mk_fwd, hipFuncAttributeMaxDynamicSharedMemorySize, LDS_BYTES) != hipSuccess) { fprintf(stderr, "kernel_launch: hipFuncSetAttribute failed\n"); grid = -1; return; }
        if (hipOccupancyMaxActiveBlocksPerMultiprocessor(&per_cu, (const void*)mk_fwd, NWAVES * 64, LDS_BYTES) != hipSuccess || per_cu < 1) { fprintf(stderr, "kernel_launch: occupancy query says %d\n", per_cu); (void)hipGetLastError(); grid = -1; return; }
        grid = cus;
    }
    if (grid < 0) return;
    (void)hipMemsetAsync((char*)d_ws + WS_CTL, 0, CTL_ZERO_BYTES, stream);
    Args a{};
    for (int i = 0; i < 12; ++i) a.in[i] = (const float*)d_in[i];
    a.out = (float*)d_out; a.ws = (unsigned char*)d_ws;
#ifndef MK_STOP
#define MK_STOP N_PHASES
#endif
#if MK_ONE_LAUNCH
    a.ph_lo = 0; a.ph_hi = MK_STOP;
    hipLaunchKernelGGL(mk_fwd, dim3(grid), dim3(NWAVES * 64), LDS_BYTES, stream, a);
#else
    for (int ph = 0; ph < MK_STOP; ++ph) {
        a.ph_lo = ph; a.ph_hi = ph + 1;
        hipLaunchKernelGGL(mk_fwd, dim3(grid), dim3(NWAVES * 64), LDS_BYTES, stream, a);
    }
#endif
#ifdef MK_DUMP
    a.ph_lo = MK_DUMP; a.ph_hi = MK_DUMP + 1; hipLaunchKernelGGL(mk_fwd, dim3(grid), dim3(NWAVES * 64), LDS_BYTES, stream, a);
#endif
}
```

```cpp
#include <hip/hip_runtime.h>
#include <cstdio>
#include <cstdint>


#ifndef MK_ONE_LAUNCH
#define MK_ONE_LAUNCH 1
#endif

#define LAS __attribute__((address_space(3)))
#define GAS __attribute__((address_space(1)))
typedef unsigned short bf16_t;
typedef short bf16x8 __attribute__((ext_vector_type(8)));
typedef float f32x4 __attribute__((ext_vector_type(4)));
typedef float f32x2 __attribute__((ext_vector_type(2)));
typedef unsigned u32x4 __attribute__((ext_vector_type(4)));
typedef unsigned u32x2 __attribute__((ext_vector_type(2)));

constexpr int BATCH = 4, SEQ = 8192, D = 1024, M = BATCH * SEQ;
constexpr int FF = 2816, FF2 = 5632, NH = 4, DK = 256, DV = 512, VTOT = 2048, RIN = 6144, NCH = 64;
constexpr float EPS = 1e-6f;
__device__ __forceinline__ float l2gamma(int h) { return h == 0 ? -0.04580368961312479f : h == 1 ? -0.02272007650008353f : h == 2 ? -0.011315313227834146f : -0.005646563141142063f; }

typedef __bf16 bf16x2_t __attribute__((ext_vector_type(2)));
__device__ __forceinline__ unsigned cvt_pk_bf16(float lo, float hi) { const f32x2 v = {lo, hi}; return __builtin_bit_cast(unsigned, __builtin_convertvector(v, bf16x2_t)); }
__device__ __forceinline__ unsigned f2bf(float f) { unsigned u = __builtin_bit_cast(unsigned, f); return (u + 0x7fffu + ((u >> 16) & 1u)) >> 16; }
__device__ __forceinline__ float bf2f(unsigned short b) { return __builtin_bit_cast(float, ((unsigned)b) << 16); }
__device__ __forceinline__ float sigmoidf_(float x) { return __builtin_amdgcn_rcpf(1.0f + __builtin_amdgcn_exp2f(-1.4426950408889634f * x)); }

namespace pg8 {
constexpr int BM = 256, BK = 64, HALF = 128, HTB = HALF * BK * 2, STAGE_BYTES = 8 * HTB, NXCD = 8, WGM = 8;
__host__ __device__ __forceinline__ int lds_byte(int r, int c) { const int st = (r >> 4) * 2 + (c >> 5), rr = r & 15, cc = c & 31, ob = rr * 64 + cc * 2; return st * 1024 + (ob ^ (((ob >> 9) & 1) << 5)); }
__host__ __device__ __forceinline__ void stage_rc(int b, int& R, int& C) { const int st = b / 1024, sb = b % 1024, swz = sb ^ (((sb >> 9) & 1) << 5); R = (st >> 1) * 16 + swz / 64; C = (st & 1) * 32 + (swz % 64) / 2; }
__host__ __device__ __forceinline__ int perm32(int rho) { const int n = rho >> 4, i = rho & 15; return 8 * (i >> 2) + 4 * n + (i & 3); }

struct Unit { int pm, pn; };
struct Gemm { const bf16_t* A; const bf16_t* Bt; int M, N, K, lda, apn; };

struct StaticOrder {
    int nM, nN, nwg, G, c;
    __host__ __device__ void init(int M_, int N_, int G_, int c_) { nM = M_ / BM; nN = N_ / BM; nwg = nM * nN; G = G_; c = c_; }
    __host__ __device__ bool next(int i, Unit& u) const {
        const long L = (long)i * G + c; if (L >= nwg) return false;
        int wgid = (int)L; { const int q = nwg / NXCD, r = nwg % NXCD, xcd = wgid % NXCD, off = wgid / NXCD; wgid = (xcd < r ? xcd * (q + 1) : r * (q + 1) + (xcd - r) * q) + off; }
        const int nig = WGM * nN, gid = wgid / nig, fm = gid * WGM, gsz = (nM - fm) < WGM ? (nM - fm) : WGM;
        u.pm = fm + ((wgid % nig) % gsz); u.pn = (wgid % nig) / gsz; return true;
    }
};

typedef f32x4 Acc[2][2][4][2];

struct EpiF32 {
    static constexpr bool PERM = false;
    float* C; int ldc;
    __device__ __forceinline__ void operator()(Acc& acc, const Unit& u, int wr, int wc, int fr, int fq, LAS unsigned char*, int, int) const {
        const int row0 = u.pm * BM + wr * 64 + fr, col0 = u.pn * BM + wc * 32 + 4 * fq;
#pragma unroll
        for (int ai = 0; ai < 2; ++ai)
#pragma unroll
            for (int m = 0; m < 4; ++m) { float* rowp = C + (size_t)(row0 + ai * HALF + m * 16) * ldc + col0;
#pragma unroll
                for (int bj = 0; bj < 2; ++bj)
#pragma unroll
                    for (int n = 0; n < 2; ++n) *(f32x4*)(rowp + bj * HALF + n * 16) = acc[ai][bj][m][n]; }
    }
};

struct EpiConvGlu {
    static constexpr bool PERM = true;
    bf16_t* act; float* halo; const float* cw; const float* cb;
    __device__ __forceinline__ void operator()(Acc& acc, const Unit& u, int wr, int wc, int fr, int fq, LAS unsigned char* xl, int wid, int lane) const {
        LAS f32x4* EX = (LAS f32x4*)xl;
        const int jc = u.pn * 128 + wc * 32 + 8 * fq;
        if (fr >= 14) {
#pragma unroll
            for (int ai = 0; ai < 2; ++ai)
#pragma unroll
                for (int bj = 0; bj < 2; ++bj)
#pragma unroll
                    for (int n = 0; n < 2; ++n) EX[((((wid * 2 + ai) * 2 + bj) * 2 + n) * 4 + fq) * 2 + (fr - 14)] = acc[ai][bj][3][n];
            if (wr == 1) {
#pragma unroll
                for (int bj = 0; bj < 2; ++bj)
#pragma unroll
                    for (int n = 0; n < 2; ++n) *(f32x4*)(halo + (size_t)(u.pm * 4 + 2 + (fr - 14)) * FF2 + bj * FF + jc + 4 * n) = acc[1][bj][3][n];
            }
        }
        if (wr == 0 && fr < 2) {
#pragma unroll
            for (int bj = 0; bj < 2; ++bj)
#pragma unroll
                for (int n = 0; n < 2; ++n) *(f32x4*)(halo + (size_t)(u.pm * 4 + fr) * FF2 + bj * FF + jc + 4 * n) = acc[0][bj][0][n];
        }
        asm volatile("s_waitcnt lgkmcnt(0)" ::: "memory"); __builtin_amdgcn_s_barrier(); asm volatile("" ::: "memory");
        const int idx1 = ((((lane & 15) - 1) & 15) | (lane & 48)) << 2, idx2 = ((((lane & 15) - 2) & 15) | (lane & 48)) << 2;
        const int srcw = (1 - wr) * 4 + wc;
#pragma unroll
        for (int n = 0; n < 2; ++n) {
            f32x4 wg[3], wv[3];
#pragma unroll
            for (int t = 0; t < 3; ++t) { wg[t] = *(const f32x4*)(cw + t * FF2 + jc + 4 * n); wv[t] = *(const f32x4*)(cw + t * FF2 + FF + jc + 4 * n); }
            const f32x4 bg = *(const f32x4*)(cb + jc + 4 * n), bv = *(const f32x4*)(cb + FF + jc + 4 * n);
#pragma unroll
            for (int ai = 0; ai < 2; ++ai) {
                f32x4 pg = (f32x4){0.f, 0.f, 0.f, 0.f}, pv = pg;
                if (!(ai == 0 && wr == 0)) { const int as = ai & wr;
                    pg = EX[((((srcw * 2 + as) * 2 + 0) * 2 + n) * 4 + fq) * 2 + (fr & 1)];
                    pv = EX[((((srcw * 2 + as) * 2 + 1) * 2 + n) * 4 + fq) * 2 + (fr & 1)]; }
#pragma unroll
                for (int m = 0; m < 4; ++m) {
                    const f32x4 xg = acc[ai][0][m][n], xv = acc[ai][1][m][n];
                    f32x4 a;
#pragma unroll
                    for (int e = 0; e < 4; ++e) {
                        const float t1g = fr == 15 ? pg[e] : xg[e], t2g = fr >= 14 ? pg[e] : xg[e], t1v = fr == 15 ? pv[e] : xv[e], t2v = fr >= 14 ? pv[e] : xv[e];
                        const float p1g = __builtin_bit_cast(float, __builtin_amdgcn_ds_bpermute(idx1, __builtin_bit_cast(int, t1g)));
                        const float p2g = __builtin_bit_cast(float, __builtin_amdgcn_ds_bpermute(idx2, __builtin_bit_cast(int, t2g)));
                        const float p1v = __builtin_bit_cast(float, __builtin_amdgcn_ds_bpermute(idx1, __builtin_bit_cast(int, t1v)));
                        const float p2v = __builtin_bit_cast(float, __builtin_amdgcn_ds_bpermute(idx2, __builtin_bit_cast(int, t2v)));
                        const float cg = bg[e] + wg[0][e] * p2g + wg[1][e] * p1g + wg[2][e] * xg[e];
                        const float cv = bv[e] + wv[0][e] * p2v + wv[1][e] * p1v + wv[2][e] * xv[e];
                        a[e] = cg * sigmoidf_(cg) * cv;
                    }
                    const bool skip = (ai == 0) && (wr == 0) && (m == 0) && (fr < 2);
                    if (!skip) { u32x2 w; w.x = cvt_pk_bf16(a[0], a[1]); w.y = cvt_pk_bf16(a[2], a[3]);
                        *(u32x2*)(act + (size_t)(u.pm * BM + ai * HALF + wr * 64 + m * 16 + fr) * FF + jc + 4 * n) = w; }
                    pg = xg; pv = xv;
                }
            }
        }
    }
};

__device__ __forceinline__ void tstore16(LAS unsigned short* T, const f32x4 (&v)[4], bf16_t* out, int ch0, int n, int j64, int fr, int fq, int lane) {
#pragma unroll
    for (int m = 0; m < 4; ++m)
#pragma unroll
        for (int e = 0; e < 4; ++e) T[(4 * fq + e) * 72 + 16 * m + fr] = (unsigned short)f2bf(v[m][e]);
    asm volatile("s_waitcnt lgkmcnt(0)" ::: "memory");
    u32x4 dd[2];
#pragma unroll
    for (int k = 0; k < 2; ++k) dd[k] = *(const LAS u32x4*)(T + (8 * k + (lane >> 3)) * 72 + 8 * (lane & 7));
    asm volatile("s_waitcnt lgkmcnt(0)" ::: "memory");
#pragma unroll
    for (int k = 0; k < 2; ++k) { const int c = 8 * k + (lane >> 3);
        const int ch = ch0 + 8 * (c >> 2) + 4 * n + (c & 3), j0 = j64 + 8 * (lane & 7);
        *(u32x4*)(out + (size_t)(((ch >> 4) * 4 + (j0 >> 5)) * 512 + ((((j0 & 31) >> 3) * 16 + (ch & 15)) * 8))) = dd[k]; }
}

struct EpiRetA {
    static constexpr bool PERM = true;
    bf16_t *Q, *K, *KT, *VT; const int* pos;
    __device__ __forceinline__ void operator()(Acc& acc, const Unit& u, int wr, int wc, int fr, int fq, LAS unsigned char* xl, int wid, int lane) const {
        LAS unsigned short* T = (LAS unsigned short*)(xl + 8192 + wid * 2304);
        const int pn = u.pn;
        if (pn < 8) {
            const bool isk = pn >= 4; const int h = pn & 3; const float sc = isk ? 1.0f : 0.0625f;
            float fv[2][4];
#pragma unroll
            for (int n = 0; n < 2; ++n)
#pragma unroll
                for (int e = 0; e < 4; ++e) fv[n][e] = __builtin_amdgcn_exp2f(-(float)(wc * 32 + 8 * fq + 4 * n + e) * (13.287712379549449f / 128.0f)) * 0.15915494309189535f;
            bf16_t* dst = isk ? K : Q;
#pragma unroll
            for (int ai = 0; ai < 2; ++ai)
#pragma unroll
                for (int m = 0; m < 4; ++m) { const int row = u.pm * BM + ai * HALF + wr * 64 + m * 16 + fr; const float p = (float)pos[row];
#pragma unroll
                    for (int n = 0; n < 2; ++n)
#pragma unroll
                        for (int e = 0; e < 4; ++e) { const float rev = __builtin_amdgcn_fractf(p * fv[n][e]); const float c = __builtin_amdgcn_cosf(rev) * sc, s = __builtin_amdgcn_sinf(rev) * sc;
                            const float x1 = acc[ai][0][m][n][e], x2 = acc[ai][1][m][n][e]; acc[ai][0][m][n][e] = x1 * c - x2 * s; acc[ai][1][m][n][e] = x2 * c + x1 * s; }
#pragma unroll
                    for (int bj = 0; bj < 2; ++bj) { const f32x4 v0 = acc[ai][bj][m][0], v1 = acc[ai][bj][m][1]; u32x4 w; w.x = cvt_pk_bf16(v0[0], v0[1]); w.y = cvt_pk_bf16(v0[2], v0[3]); w.z = cvt_pk_bf16(v1[0], v1[1]); w.w = cvt_pk_bf16(v1[2], v1[3]);
                        *(u32x4*)(dst + ((size_t)(row >> 4) * 32 + 8 * h + 4 * bj + wc) * 512 + lane * 8) = w; } }
            if (isk) {
                float dk[4];
#pragma unroll
                for (int m = 0; m < 4; ++m) dk[m] = __builtin_amdgcn_exp2f((float)(127 - (64 * wr + 16 * m + fr)) * l2gamma(h));
#pragma unroll
                for (int ai = 0; ai < 2; ++ai)
#pragma unroll
                    for (int bj = 0; bj < 2; ++bj)
#pragma unroll
                        for (int n = 0; n < 2; ++n) { f32x4 v[4];
#pragma unroll
                            for (int m = 0; m < 4; ++m) v[m] = acc[ai][bj][m][n] * dk[m];
                            const int g = 2 * u.pm + ai;
                            tstore16(T, v, KT + (size_t)((((g >> 6) * NH + h) * NCH) + (g & 63)) * (DK * 128), bj * HALF + wc * 32, n, 64 * wr, fr, fq, lane); }
            }
        } else {
#pragma unroll
            for (int ai = 0; ai < 2; ++ai)
#pragma unroll
                for (int bj = 0; bj < 2; ++bj)
#pragma unroll
                    for (int n = 0; n < 2; ++n) { f32x4 v[4];
#pragma unroll
                        for (int m = 0; m < 4; ++m) v[m] = acc[ai][bj][m][n];
                        const int g = 2 * u.pm + ai, hv = (pn - 8) >> 1;
                        tstore16(T, v, VT + (size_t)((((g >> 6) * NH + hv) * NCH) + (g & 63)) * (DV * 128), 256 * ((pn - 8) & 1) + bj * HALF + wc * 32, n, 64 * wr, fr, fq, lane); }
        }
    }
};

struct EpiRetB {
    static constexpr bool PERM = true;
    const bf16_t* O; const long long* stats; const float* gn; bf16_t* Y;
    __device__ __forceinline__ void operator()(Acc& acc, const Unit& u, int wr, int wc, int fr, int fq, LAS unsigned char*, int, int) const {
        const int h = u.pn >> 1, cb0 = u.pn * BM + wc * 32 + 8 * fq;
        f32x4 gg[2][2];
#pragma unroll
        for (int bj = 0; bj < 2; ++bj)
#pragma unroll
            for (int n = 0; n < 2; ++n) gg[bj][n] = *(const f32x4*)(gn + cb0 + bj * HALF + 4 * n);
#pragma unroll
        for (int ai = 0; ai < 2; ++ai)
#pragma unroll
            for (int m = 0; m < 4; ++m) { const int row = u.pm * BM + ai * HALF + wr * 64 + m * 16 + fr; const int b = row >> 13, s = row & (SEQ - 1);
                const float s1 = (float)((double)stats[(size_t)((b * NH + h) * 2 + 0) * SEQ + s] * (1.0 / 16777216.0)), s2 = (float)((double)stats[(size_t)((b * NH + h) * 2 + 1) * SEQ + s] * (1.0 / 16777216.0));
                const float mu = s1 * (1.0f / DV), var = s2 * (1.0f / DV) - mu * mu, rstd = 1.0f / sqrtf(fmaxf(var, 0.f) + EPS);
#pragma unroll
                for (int bj = 0; bj < 2; ++bj) { const u32x4 ow = *(const u32x4*)(O + ((size_t)(row >> 4) * 64 + 8 * u.pn + 4 * bj + wc) * 512 + (fq * 16 + fr) * 8);
                    float o[8]; o[0] = __builtin_bit_cast(float, ow.x << 16); o[1] = __builtin_bit_cast(float, ow.x & 0xffff0000u); o[2] = __builtin_bit_cast(float, ow.y << 16); o[3] = __builtin_bit_cast(float, ow.y & 0xffff0000u);
                    o[4] = __builtin_bit_cast(float, ow.z << 16); o[5] = __builtin_bit_cast(float, ow.z & 0xffff0000u); o[6] = __builtin_bit_cast(float, ow.w << 16); o[7] = __builtin_bit_cast(float, ow.w & 0xffff0000u);
                    float y[8];
#pragma unroll
                    for (int n = 0; n < 2; ++n)
#pragma unroll
                        for (int e = 0; e < 4; ++e) { const float g = acc[ai][bj][m][n][e]; y[4 * n + e] = (o[4 * n + e] - mu) * rstd * gg[bj][n][e] * (g * sigmoidf_(g)); }
                    u32x4 w; w.x = cvt_pk_bf16(y[0], y[1]); w.y = cvt_pk_bf16(y[2], y[3]); w.z = cvt_pk_bf16(y[4], y[5]); w.w = cvt_pk_bf16(y[6], y[7]);
                    *(u32x4*)(Y + (size_t)row * VTOT + cb0 + bj * HALF) = w; } }
    }
};

template <class Epi, bool ALIGN_EPI = true, bool SP2 = true>
__device__ __forceinline__ void gemm_phase(LAS unsigned char* lds, LAS unsigned char* xl, const Gemm g, const StaticOrder& S, const Epi& E) {
    const int tid = threadIdx.x, wid = __builtin_amdgcn_readfirstlane(tid >> 6), lane = tid & 63, wr = wid >> 2, wc = wid & 3, fr = lane & 15, fq = lane >> 4;
    const int K = g.K, nt = K / BK, lda = g.lda;
    unsigned voffA[2], voffB[2];
#pragma unroll
    for (int i = 0; i < 2; ++i) { int R, C; stage_rc(tid * 16 + i * 8192, R, C); const int Rb = Epi::PERM ? ((R & ~31) + perm32(R & 31)) : R;
        voffA[i] = (unsigned)(R * lda + C) * 2u; voffB[i] = (unsigned)(Rb * K + C) * 2u; }
    const size_t kstep = (size_t)(BK * 2);
    const size_t hstepA = (size_t)HALF * lda * 2, hstepB = (size_t)HALF * K * 2;
    const size_t tstepA = 2 * hstepA, tstepB = 2 * hstepB;
    const unsigned ldsw = (unsigned)wid * 1024u;
    const int aoff = lds_byte(wr * 64 + fr, fq * 8), boff = lds_byte(wc * 32 + fr, fq * 8);
#define PG8_SA(b, h) (((b) * 2 + (h)) * HTB)
#define PG8_SB(b, h) ((4 + (b) * 2 + (h)) * HTB)
#define PG8_STAGE(bufoff, gbase, voff) do { _Pragma("unroll") for (int _i = 0; _i < 2; ++_i) \
        __builtin_amdgcn_global_load_lds((const unsigned*)((const char*)(gbase) + (voff)[_i]), (LAS unsigned*)(lds + (bufoff) + ldsw + _i * 8192), 16, 0, 0); } while (0)
#define PG8_LDA(dst, b, h) do { _Pragma("unroll") for (int m = 0; m < 4; ++m) _Pragma("unroll") for (int k = 0; k < 2; ++k) dst[m][k] = *(const LAS bf16x8*)(lds + PG8_SA(b, h) + aoff + m * 2048 + k * 1024); } while (0)
#define PG8_LDB(dst, b, h) do { _Pragma("unroll") for (int n = 0; n < 2; ++n) _Pragma("unroll") for (int k = 0; k < 2; ++k) dst[n][k] = *(const LAS bf16x8*)(lds + PG8_SB(b, h) + boff + n * 2048 + k * 1024); } while (0)
#define PG8_MMA(ai, bj, At, Bt) do { __builtin_amdgcn_s_setprio(1); _Pragma("unroll") for (int m = 0; m < 4; ++m) _Pragma("unroll") for (int n = 0; n < 2; ++n) _Pragma("unroll") for (int k = 0; k < 2; ++k) \
        acc[ai][bj][m][n] = __builtin_amdgcn_mfma_f32_16x16x32_bf16(Bt[n][k], At[m][k], acc[ai][bj][m][n], 0, 0, 0); __builtin_amdgcn_s_setprio(0); } while (0)
#define PG8_WAIT_V(n) asm volatile("s_waitcnt vmcnt(" #n ")" ::: "memory")
#define PG8_WAIT_L(n) asm volatile("s_waitcnt lgkmcnt(" #n ")" ::: "memory")
#define PG8_BAR __builtin_amdgcn_s_barrier()
#define PG8_SCHED __builtin_amdgcn_sched_barrier(0)
    Unit cur, nxt; int ui = 0;
    if (!S.next(0, cur)) return;
    Acc acc;
#pragma unroll
    for (int a = 0; a < 2; ++a)
#pragma unroll
        for (int b = 0; b < 2; ++b)
#pragma unroll
            for (int m = 0; m < 4; ++m)
#pragma unroll
                for (int n = 0; n < 2; ++n) acc[a][b][m][n] = (f32x4){0.f, 0.f, 0.f, 0.f};
    bf16x8 At[4][2], B0[2][2], B1[2][2];
    const char* cA = (const char*)g.A + (size_t)cur.pm * tstepA + (size_t)cur.pn * g.apn * 2; const char* cB = (const char*)g.Bt + (size_t)cur.pn * tstepB;
    if constexpr (SP2) {
        PG8_STAGE(PG8_SB(0, 0), cB, voffB); PG8_STAGE(PG8_SB(0, 1), cB + hstepB, voffB); PG8_STAGE(PG8_SA(0, 0), cA, voffA); PG8_STAGE(PG8_SA(0, 1), cA + hstepA, voffA);
        if (wr == 1) PG8_BAR;
        PG8_WAIT_V(2); PG8_BAR;
        PG8_STAGE(PG8_SB(1, 0), cB + kstep, voffB); PG8_STAGE(PG8_SA(1, 0), cA + kstep, voffA); PG8_STAGE(PG8_SB(1, 1), cB + hstepB + kstep, voffB);
        PG8_WAIT_V(6); PG8_BAR;
    } else {
        PG8_STAGE(PG8_SB(0, 0), cB, voffB); PG8_STAGE(PG8_SA(0, 0), cA, voffA); PG8_STAGE(PG8_SB(0, 1), cB + hstepB, voffB); PG8_STAGE(PG8_SA(0, 1), cA + hstepA, voffA);
        if (wr == 1) PG8_BAR;
        PG8_WAIT_V(4); PG8_BAR;
        PG8_STAGE(PG8_SB(1, 0), cB + kstep, voffB); PG8_STAGE(PG8_SA(1, 0), cA + kstep, voffA); PG8_STAGE(PG8_SB(1, 1), cB + hstepB + kstep, voffB);
        PG8_WAIT_V(6); PG8_BAR;
    }
    for (;;) {
        const bool has_next = S.next(ui + 1, nxt);
        const char* nA = has_next ? (const char*)g.A + (size_t)nxt.pm * tstepA + (size_t)nxt.pn * g.apn * 2 : cA; const char* nB = has_next ? (const char*)g.Bt + (size_t)nxt.pn * tstepB : cB;
        for (int t = 0; t < nt; t += 2) {
            const bool last = (t == nt - 2);
            const char* a1 = cA + (size_t)(t + 1) * kstep;
            const char* a2 = last ? nA : cA + (size_t)(t + 2) * kstep; const char* b2 = last ? nB : cB + (size_t)(t + 2) * kstep;
            const char* a3 = a2 + kstep; const char* b3 = b2 + kstep;
            if constexpr (SP2) {
            PG8_LDB(B0, 0, 0); PG8_LDB(B1, 0, 1); PG8_SCHED; PG8_LDA(At, 0, 0); PG8_STAGE(PG8_SA(1, 1), a1 + hstepA, voffA);
            PG8_WAIT_V(8); PG8_WAIT_L(0); PG8_BAR; PG8_MMA(0, 0, At, B0); PG8_MMA(0, 1, At, B1); PG8_BAR; PG8_SCHED;
            PG8_LDA(At, 0, 1); PG8_STAGE(PG8_SB(0, 0), b2, voffB); PG8_STAGE(PG8_SB(0, 1), b2 + hstepB, voffB); PG8_STAGE(PG8_SA(0, 0), a2, voffA);
            PG8_WAIT_V(8); PG8_WAIT_L(0); PG8_BAR; PG8_MMA(1, 0, At, B0); PG8_MMA(1, 1, At, B1); PG8_BAR; PG8_SCHED;
            PG8_LDB(B0, 1, 0); PG8_LDB(B1, 1, 1); PG8_SCHED; PG8_LDA(At, 1, 0); PG8_STAGE(PG8_SA(0, 1), a2 + hstepA, voffA);
            PG8_WAIT_V(8); PG8_WAIT_L(0); PG8_BAR; PG8_MMA(0, 0, At, B0); PG8_MMA(0, 1, At, B1); PG8_BAR; PG8_SCHED;
            PG8_LDA(At, 1, 1); PG8_STAGE(PG8_SB(1, 0), b3, voffB); PG8_STAGE(PG8_SB(1, 1), b3 + hstepB, voffB); PG8_STAGE(PG8_SA(1, 0), a3, voffA);
            PG8_WAIT_V(8); PG8_WAIT_L(0); PG8_BAR; PG8_MMA(1, 0, At, B0); PG8_MMA(1, 1, At, B1); PG8_BAR; PG8_SCHED;
            } else {
            PG8_LDB(B0, 0, 0); PG8_SCHED; PG8_LDA(At, 0, 0); PG8_STAGE(PG8_SA(1, 1), a1 + hstepA, voffA);
            PG8_WAIT_L(8); PG8_BAR; PG8_WAIT_L(0); PG8_MMA(0, 0, At, B0); PG8_BAR; PG8_SCHED;
            PG8_LDB(B1, 0, 1); PG8_STAGE(PG8_SB(0, 0), b2, voffB);
            PG8_BAR; PG8_WAIT_L(0); PG8_MMA(0, 1, At, B1); PG8_BAR;
            PG8_LDA(At, 0, 1); PG8_STAGE(PG8_SA(0, 0), a2, voffA);
            PG8_BAR; PG8_WAIT_L(0); PG8_MMA(1, 0, At, B0); PG8_BAR; PG8_SCHED;
            PG8_STAGE(PG8_SB(0, 1), b2 + hstepB, voffB);
            PG8_WAIT_V(6); PG8_BAR; PG8_MMA(1, 1, At, B1); PG8_BAR;
            PG8_LDB(B0, 1, 0); PG8_SCHED; PG8_LDA(At, 1, 0); PG8_STAGE(PG8_SA(0, 1), a2 + hstepA, voffA);
            PG8_WAIT_L(8); PG8_BAR; PG8_WAIT_L(0); PG8_MMA(0, 0, At, B0); PG8_BAR; PG8_SCHED;
            PG8_LDB(B1, 1, 1); PG8_STAGE(PG8_SB(1, 0), b3, voffB);
            PG8_BAR; PG8_WAIT_L(0); PG8_MMA(0, 1, At, B1); PG8_BAR;
            PG8_LDA(At, 1, 1); PG8_STAGE(PG8_SA(1, 0), a3, voffA);
            PG8_BAR; PG8_WAIT_L(0); PG8_MMA(1, 0, At, B0); PG8_BAR; PG8_SCHED;
            PG8_STAGE(PG8_SB(1, 1), b3 + hstepB, voffB);
            PG8_WAIT_V(6); PG8_BAR; PG8_MMA(1, 1, At, B1); PG8_BAR;
            }
        }
        if constexpr (ALIGN_EPI) { if (wr == 0) PG8_BAR; }
        E(acc, cur, wr, wc, fr, fq, xl, wid, lane);
        if (!has_next) break;
#pragma unroll
        for (int a = 0; a < 2; ++a)
#pragma unroll
            for (int b = 0; b < 2; ++b)
#pragma unroll
                for (int m = 0; m < 4; ++m)
#pragma unroll
                    for (int n = 0; n < 2; ++n) acc[a][b][m][n] = (f32x4){0.f, 0.f, 0.f, 0.f};
        cur = nxt; cA = nA; cB = nB; ++ui;
        if constexpr (ALIGN_EPI) { if (wr == 1) PG8_BAR; }
    }
    PG8_WAIT_V(0);
    if constexpr (!ALIGN_EPI) { if (wr == 0) PG8_BAR; }
    PG8_BAR;
#undef PG8_SA
#undef PG8_SB
#undef PG8_STAGE
#undef PG8_LDA
#undef PG8_LDB
#undef PG8_MMA
#undef PG8_WAIT_V
#undef PG8_WAIT_L
#undef PG8_BAR
#undef PG8_SCHED
}
}

constexpr size_t MiB = 1u << 20;
constexpr size_t WS_CTL = 0, WS_STATS = 1 * MiB, CTL_ZERO_BYTES = 3 * MiB;
constexpr size_t WS_WIN = 3 * MiB, WS_WOUT = 15 * MiB;
constexpr size_t WS_HN = 19 * MiB;
constexpr size_t WS_DIFF = 83 * MiB;
constexpr size_t WS_FA = 147 * MiB, WS_FB = 352 * MiB, WS_FC = 275 * MiB;
constexpr size_t WS_ACT = 147 * MiB, WS_HALO = 323 * MiB;
constexpr size_t WS_WPOOL = 334 * MiB, WS_WUP0 = 335 * MiB, WS_WDN0 = 346 * MiB;
constexpr size_t WS_Q = 83 * MiB, WS_KT = 147 * MiB, WS_VT = 211 * MiB, WS_P = 339 * MiB, WS_K = 371 * MiB, WS_O = 371 * MiB;
constexpr size_t WS_WUP1 = 83 * MiB, WS_WDN1 = 94 * MiB;
constexpr size_t WS_Y = 147 * MiB;
constexpr size_t WS_END = 512 * MiB;

constexpr int RING_BYTES = 131072, XL_OFF = RING_BYTES, XL_BYTES = 8192 + 8 * 2304, MISC_OFF = XL_OFF + XL_BYTES;
constexpr int LDS_BYTES = 163840 - 4096;
static_assert(MISC_OFF + 256 <= LDS_BYTES, "LDS map");
constexpr int NWAVES = 8;

typedef GAS unsigned gu32;
#define RLX_AGENT __ATOMIC_RELAXED, __HIP_MEMORY_SCOPE_AGENT
#define XB_TMO      128
#define XB_XCNT(j)  (256  + 64 * (j))
#define XB_XSUB(j)  (1280 + 64 * (j))
#define XB_XGEN(j)  (2304 + 64 * (j))
#define XB_TOP      3328
#define XB_TOPGEN   3392
#define XCD_BAR_WORDS 3456
#define XB_SPIN_CAP (1u << 18)
__device__ __forceinline__ unsigned xb_ld(unsigned* p)              { return __hip_atomic_load(p, __ATOMIC_RELAXED, __HIP_MEMORY_SCOPE_AGENT); }
__device__ __forceinline__ unsigned xb_add(unsigned* p, unsigned v) { return __hip_atomic_fetch_add(p, v, __ATOMIC_RELAXED, __HIP_MEMORY_SCOPE_AGENT); }
__device__ __forceinline__ unsigned xb_xcc_id() { return (unsigned)__builtin_amdgcn_s_getreg((3 << 11) | 20) & 0xFu; }
#define XB_SPIN(cond, bar) do { unsigned _sp = 0; while (cond) { __builtin_amdgcn_s_sleep(1); \
    if ((++_sp & 255u) == 0u) { if (xb_ld(&(bar)[XB_TMO])) break; if (_sp > XB_SPIN_CAP) { atomicAdd(&(bar)[XB_TMO], 1u); break; } } } } while (0)
struct XcdBarrier { unsigned* bar; unsigned x; volatile LAS unsigned* st; };
__device__ __forceinline__ XcdBarrier xcd_barrier_post(unsigned* bar, volatile LAS unsigned* st) {
    XcdBarrier b; b.bar = bar; b.x = xb_xcc_id(); b.st = st;
    if (threadIdx.x == 0) (void)xb_add(&bar[XB_XCNT(b.x)], 1u);
    return b;
}
__device__ __forceinline__ void xcd_barrier_complete(unsigned* bar, unsigned x, unsigned& nloc, unsigned& nx) {
    const unsigned G = gridDim.x * gridDim.y * gridDim.z;
    unsigned sum, cnt, mine, sp = 0u;
    for (;;) {
        sum = 0u; cnt = 0u; mine = 0u;
#pragma unroll
        for (unsigned j = 0; j < 16; ++j) { const unsigned c = xb_ld(&bar[XB_XCNT(j)]); sum += c; cnt += (c > 0u) ? 1u : 0u; mine = (j == x) ? c : mine; }
        if (sum == G) break;
        __builtin_amdgcn_s_sleep(1);
        if ((++sp & 255u) == 0u) { if (xb_ld(&bar[XB_TMO])) break; if (sp > XB_SPIN_CAP) { atomicAdd(&bar[XB_TMO], 1u); break; } }
    }
    nloc = mine > 0u ? mine : 1u; nx = cnt > 0u ? cnt : 1u;
}
__device__ __forceinline__ void xcd_barrier(const XcdBarrier& b) {
    asm volatile("s_waitcnt vmcnt(0)" ::: "memory");
    __syncthreads();
    if (threadIdx.x == 0) {
        unsigned* bar = b.bar;
        __builtin_amdgcn_s_waitcnt(0);
        unsigned nloc = b.st[0], nx = b.st[1];
        if (nloc == 0u) { xcd_barrier_complete(bar, b.x, nloc, nx); b.st[0] = nloc; b.st[1] = nx; }
        const unsigned old = xb_add(&bar[XB_XSUB(b.x)], 1u);
        const unsigned gen = old / nloc;
        if (old + 1u == (gen + 1u) * nloc) {
            __builtin_amdgcn_fence(__ATOMIC_RELEASE, "agent");
            asm volatile("s_waitcnt vmcnt(0)" ::: "memory");
            const unsigned og = xb_add(&bar[XB_TOP], 1u);
            const unsigned tg = og / nx;
            if (og + 1u == (tg + 1u) * nx) xb_add(&bar[XB_TOPGEN], 1u);
            else XB_SPIN(xb_ld(&bar[XB_TOPGEN]) == tg, bar);
            __builtin_amdgcn_fence(__ATOMIC_ACQUIRE, "agent");
            xb_add(&bar[XB_XGEN(b.x)], 1u);
            asm volatile("s_waitcnt vmcnt(0)" ::: "memory");
        } else {
            XB_SPIN(xb_ld(&bar[XB_XGEN(b.x)]) == gen, bar);
            __builtin_amdgcn_fence(__ATOMIC_ACQUIRE, "agent");
            asm volatile("s_waitcnt vmcnt(0)" ::: "memory");
        }
    }
    __syncthreads();
}
constexpr int CW_BAR = 4096;

struct Frame {
    LAS unsigned char* lds;
    int tid, lane, wave, G;
    const float* in[12]; float* out; unsigned char* ws;
};

__device__ __forceinline__ float wave_sum(float v) {
#pragma unroll
    for (int o = 1; o < 64; o <<= 1) v += __shfl_xor(v, o);
    return v;
}

__device__ __forceinline__ void transpose_item(const float* W, int K, int N, bf16_t* WT, int k0, int n0, int drow0, LAS float* scr, int lane) {
#pragma unroll 8
    for (int i = 0; i < 32; ++i) { const int kk = 2 * i + (lane >> 5); scr[kk * 33 + (lane & 31)] = W[(size_t)(k0 + kk) * N + n0 + (lane & 31)]; }
    asm volatile("s_waitcnt lgkmcnt(0)" ::: "memory");
    const int c = lane & 7;
#pragma unroll
    for (int j = 0; j < 4; ++j) { const int n = (lane >> 3) + 8 * j; const LAS float* s = scr + (8 * c) * 33 + n;
        u32x4 o; o.x = f2bf(s[0 * 33]) | (f2bf(s[1 * 33]) << 16); o.y = f2bf(s[2 * 33]) | (f2bf(s[3 * 33]) << 16); o.z = f2bf(s[4 * 33]) | (f2bf(s[5 * 33]) << 16); o.w = f2bf(s[6 * 33]) | (f2bf(s[7 * 33]) << 16);
        *(u32x4*)(WT + (size_t)(drow0 + n) * K + k0 + 8 * c) = o; }
    asm volatile("s_waitcnt lgkmcnt(0)" ::: "memory");
}
__device__ __forceinline__ int upmap(int n0) { return n0 < FF ? 256 * (n0 >> 7) + (n0 & 127) : 256 * ((n0 - FF) >> 7) + 128 + ((n0 - FF) & 127); }
__device__ __forceinline__ void transpose_plain(Frame& F, const float* W, int K, int N, bf16_t* WT, int it) {
    LAS float* scr = (LAS float*)(F.lds + F.wave * 16384); const int nblk = N / 32, kb = it / nblk, nb = it % nblk;
    transpose_item(W, K, N, WT, 64 * kb, 32 * nb, 32 * nb, scr, F.lane);
}
__device__ __forceinline__ void transpose_up(Frame& F, const float* W, bf16_t* WT, int it) {
    LAS float* scr = (LAS float*)(F.lds + F.wave * 16384); const int nblk = FF2 / 32, kb = it / nblk, nb = it % nblk;
    transpose_item(W, D, FF2, WT, 64 * kb, 32 * nb, upmap(32 * nb), scr, F.lane);
}

__device__ __forceinline__ void pool_diff_unit(Frame& F, int unit, const float* x, const float* gain, bf16_t* DIFF) {
    LAS float* rs = (LAS float*)(F.lds + 8 * 16384);
    const int t0 = unit * 64, ts0 = t0 & ~(SEQ - 1);
    for (int r = F.wave; r < 80; r += NWAVES) { const int t = t0 - 16 + r; float rstd = 0.f;
        if (t >= ts0) { const f32x4* xr = (const f32x4*)(x + (size_t)t * D) + F.lane; float s = 0.f;
#pragma unroll
            for (int j = 0; j < 4; ++j) { const f32x4 v = xr[64 * j]; s += (v.x * v.x + v.y * v.y) + (v.z * v.z + v.w * v.w); }
            rstd = 1.0f / sqrtf(wave_sum(s) * (1.0f / D) + EPS); }
        if (F.lane == 0) rs[r] = rstd; }
    __syncthreads();
    const int c0 = 2 * F.tid, win = 2 << (c0 >> 8);
    const f32x2 gv = *(const f32x2*)(gain + c0);
    f32x2 ring[16];
#pragma unroll
    for (int i = 0; i < 16; ++i) ring[i] = (f32x2){0.f, 0.f};
    for (int rb = 0; rb < 80; rb += 16) {
#pragma unroll
        for (int ri = 0; ri < 16; ++ri) { const int r = rb + ri, t = t0 - 16 + r;
            f32x2 h = (f32x2){0.f, 0.f};
            if (t >= ts0) { const f32x2 xv = *(const f32x2*)(x + (size_t)t * D + c0); const float rr = rs[r]; h.x = xv.x * rr * gv.x; h.y = xv.y * rr * gv.y; }
            ring[ri] = h;
            if (rb >= 16) { f32x2 s = (f32x2){0.f, 0.f};
#pragma unroll
                for (int k = 0; k < 16; ++k) if (k < win) { s.x += ring[(ri - k) & 15].x; s.y += ring[(ri - k) & 15].y; }
                const int cnt = min(t - ts0 + 1, win); const float ic = 1.0f / (float)cnt;
                *(unsigned*)(DIFF + (size_t)t * D + c0) = cvt_pk_bf16(s.x * ic - h.x, s.y * ic - h.y); } }
    }
    __syncthreads();
}

__device__ __forceinline__ void resnorm_phase(Frame& F, const float* f, const float* pscale, const float* base, float* out, const float* ga, const float* gb, bf16_t* hn) {
    const int gw = blockIdx.x * NWAVES + F.wave, NGW = F.G * NWAVES;
    f32x4 a4[4], b4[4], p4[4];
#pragma unroll
    for (int j = 0; j < 4; ++j) { a4[j] = *((const f32x4*)ga + F.lane + 64 * j); b4[j] = gb ? *((const f32x4*)gb + F.lane + 64 * j) : (f32x4){0.f, 0.f, 0.f, 0.f}; p4[j] = pscale ? *((const f32x4*)pscale + F.lane + 64 * j) : (f32x4){1.f, 1.f, 1.f, 1.f}; }
    for (int row = gw; row < M; row += NGW) {
        const f32x4* fr = (const f32x4*)(f + (size_t)row * D) + F.lane; const f32x4* br = (const f32x4*)(base + (size_t)row * D) + F.lane;
        f32x4 v[4], x[4]; float s = 0.f;
#pragma unroll
        for (int j = 0; j < 4; ++j) { v[j] = fr[64 * j] * p4[j]; x[j] = br[64 * j]; s += (v[j].x * v[j].x + v[j].y * v[j].y) + (v[j].z * v[j].z + v[j].w * v[j].w); }
        const float r = 1.0f / sqrtf(wave_sum(s) * (1.0f / D) + EPS); float s2 = 0.f;
#pragma unroll
        for (int j = 0; j < 4; ++j) { x[j] = x[j] + v[j] * r * a4[j]; s2 += (x[j].x * x[j].x + x[j].y * x[j].y) + (x[j].z * x[j].z + x[j].w * x[j].w); *((f32x4*)(out + (size_t)row * D) + F.lane + 64 * j) = x[j]; }
        if (hn) { const float r2 = 1.0f / sqrtf(wave_sum(s2) * (1.0f / D) + EPS);
#pragma unroll
            for (int j = 0; j < 4; ++j) { const f32x4 o = x[j] * r2 * b4[j]; u32x2 w; w.x = cvt_pk_bf16(o.x, o.y); w.y = cvt_pk_bf16(o.z, o.w); *((u32x2*)(hn + (size_t)row * D) + F.lane + 64 * j) = w; } }
    }
}

__device__ __forceinline__ void convfix_phase(Frame& F, const float* halo, const float* cw, const float* cb, bf16_t* act) {
    const int total = (M / 256) * 2 * FF;
    for (int i = blockIdx.x * 512 + F.tid; i < total; i += F.G * 512) {
        const int pm = i / (2 * FF), rem = i - pm * 2 * FF, rho = rem / FF, j = rem - rho * FF;
        const bool first = (pm & 31) == 0;
        float cg = cb[j], cv = cb[FF + j];
#pragma unroll
        for (int t = 0; t < 3; ++t) { const int r = rho - 2 + t; float ug = 0.f, uv = 0.f;
            if (r >= 0) { ug = halo[(size_t)(pm * 4 + r) * FF2 + j]; uv = halo[(size_t)(pm * 4 + r) * FF2 + FF + j]; }
            else if (!first) { ug = halo[(size_t)((pm - 1) * 4 + 4 + r) * FF2 + j]; uv = halo[(size_t)((pm - 1) * 4 + 4 + r) * FF2 + FF + j]; }
            cg += cw[t * FF2 + j] * ug; cv += cw[t * FF2 + FF + j] * uv; }
        act[(size_t)(pm * 256 + rho) * FF + j] = (bf16_t)f2bf(cg * sigmoidf_(cg) * cv);
    }
}

__device__ __forceinline__ void scores_phase(Frame& F, const bf16_t* Q, const bf16_t* Kr, bf16_t* P) {
    const int l15 = F.lane & 15, lq = F.lane >> 4, w = F.wave;
    for (int u = blockIdx.x; u < BATCH * NH * NCH; u += F.G) {
        const int b = u >> 8, h = (u >> 6) & 3, n = u & 63; const size_t tb0 = (size_t)b * (SEQ / 16) + 8 * n; const float l2g = l2gamma(h);
        bf16x8 qf[8];
#pragma unroll
        for (int ks = 0; ks < 8; ++ks) qf[ks] = *(const bf16x8*)(Q + ((tb0 + w) * 32 + 8 * h + ks) * 512 + F.lane * 8);
        for (int jt = 0; jt < 8; ++jt) {
            u32x2 o; o.x = 0u; o.y = 0u;
            if (jt <= w) { f32x4 acc = (f32x4){0.f, 0.f, 0.f, 0.f};
#pragma unroll
                for (int ks = 0; ks < 8; ++ks) { const bf16x8 kf = *(const bf16x8*)(Kr + ((tb0 + jt) * 32 + 8 * h + ks) * 512 + F.lane * 8); acc = __builtin_amdgcn_mfma_f32_16x16x32_bf16(kf, qf[ks], acc, 0, 0, 0); }
                float v[4];
#pragma unroll
                for (int r = 0; r < 4; ++r) { const int dij = (16 * w + l15) - (16 * jt + 4 * lq + r); v[r] = dij >= 0 ? acc[r] * __builtin_amdgcn_exp2f((float)dij * l2g) : 0.f; }
                o.x = cvt_pk_bf16(v[0], v[1]); o.y = cvt_pk_bf16(v[2], v[3]); }
            *(u32x2*)(P + (size_t)u * 16384 + (w * 4 + (jt >> 1)) * 512 + ((2 * (jt & 1) + (lq >> 1)) * 16 + l15) * 8 + 4 * (lq & 1)) = o;
        }
    }
}

struct ScanPtrs { const bf16_t* qrow; const bf16_t* prow; const bf16_t* vrow0; const bf16_t* krow0; bf16_t* orow; unsigned long long* st1; };
__device__ __forceinline__ void scan_load_v(bf16x8 (&vf)[2][4], const ScanPtrs& sp, int n) {
#pragma unroll
    for (int vt = 0; vt < 2; ++vt)
#pragma unroll
        for (int ks = 0; ks < 4; ++ks) vf[vt][ks] = *(const bf16x8*)(sp.vrow0 + (size_t)n * (DV * 128) + (vt * 4 + ks) * 512);
}
__device__ __forceinline__ void scan_load_k(bf16x8 (&kf)[2][4], const ScanPtrs& sp, int n) {
#pragma unroll
    for (int dt = 0; dt < 2; ++dt)
#pragma unroll
        for (int ks = 0; ks < 4; ++ks) kf[dt][ks] = *(const bf16x8*)(sp.krow0 + (size_t)n * (DK * 128) + (dt * 4 + ks) * 512);
}
__device__ __forceinline__ void scan_load_p(bf16x8 (&pf)[4], const ScanPtrs& sp, int n) {
#pragma unroll
    for (int ks = 0; ks < 4; ++ks) pf[ks] = *(const bf16x8*)(sp.prow + (size_t)n * 128 * 128 + ks * 512);
}
__device__ __forceinline__ void scan_load_q(bf16x8 (&qf)[8], const ScanPtrs& sp, int n) {
#pragma unroll
    for (int ks = 0; ks < 8; ++ks) qf[ks] = *(const bf16x8*)(sp.qrow + (size_t)n * 128 * D + ks * 512);
}
__device__ __forceinline__ void scan_step(int n, LAS unsigned char* ST, const ScanPtrs& sp, f32x4 (&as)[2][2], bf16x8 (&vc)[2][4], bf16x8 (&vn)[2][4], bf16x8 (&kf)[2][4], bf16x8 (&pf)[4], bf16x8 (&qf)[8],
                                          float cdk, float crd, int l15, int lq, int w, bool do_stats) {
    const int nn = n + 1 < NCH ? n + 1 : n;
    scan_load_v(vn, sp, nn);
#pragma unroll
    for (int dt = 0; dt < 2; ++dt)
#pragma unroll
        for (int vt = 0; vt < 2; ++vt) as[dt][vt] = as[dt][vt] * cdk;
#pragma unroll
    for (int ks = 0; ks < 4; ++ks)
#pragma unroll
        for (int dt = 0; dt < 2; ++dt)
#pragma unroll
            for (int vt = 0; vt < 2; ++vt) as[dt][vt] = __builtin_amdgcn_mfma_f32_16x16x32_bf16(kf[dt][ks], vc[vt][ks], as[dt][vt], 0, 0, 0);
    scan_load_k(kf, sp, nn);
    f32x4 ai[2]; ai[0] = (f32x4){0.f, 0.f, 0.f, 0.f}; ai[1] = ai[0];
#pragma unroll
    for (int ks = 0; ks < 4; ++ks)
#pragma unroll
        for (int vt = 0; vt < 2; ++vt) ai[vt] = __builtin_amdgcn_mfma_f32_16x16x32_bf16(vc[vt][ks], pf[ks], ai[vt], 0, 0, 0);
    scan_load_p(pf, sp, nn);
    f32x4 ac[2]; ac[0] = (f32x4){0.f, 0.f, 0.f, 0.f}; ac[1] = ac[0];
#pragma unroll
    for (int ks = 0; ks < 8; ++ks)
#pragma unroll
        for (int vt = 0; vt < 2; ++vt) { const bf16x8 sx = *(const LAS bf16x8*)(ST + (16 * vt + l15) * 528 + (32 * ks + 8 * lq) * 2); ac[vt] = __builtin_amdgcn_mfma_f32_16x16x32_bf16(sx, qf[ks], ac[vt], 0, 0, 0); }
    scan_load_q(qf, sp, nn);
    float s1 = 0.f, s2 = 0.f;
#pragma unroll
    for (int vt = 0; vt < 2; ++vt) { const f32x4 o4 = ai[vt] + ac[vt] * crd; u32x2 o; o.x = cvt_pk_bf16(o4[0], o4[1]); o.y = cvt_pk_bf16(o4[2], o4[3]); *(u32x2*)(sp.orow + (size_t)n * 128 * VTOT + vt * 256) = o;
#pragma unroll
        for (int r = 0; r < 4; ++r) { s1 += o4[r]; s2 += o4[r] * o4[r]; } }
    s1 += __shfl_xor(s1, 16); s1 += __shfl_xor(s1, 32); s2 += __shfl_xor(s2, 16); s2 += __shfl_xor(s2, 32);
    if (lq == 0) *(LAS f32x2*)(ST + 32768 + (size_t)(n * 128 + 16 * w + l15) * 8) = (f32x2){s1, s2};
    __syncthreads();
#pragma unroll
    for (int dt = 0; dt < 2; ++dt)
#pragma unroll
        for (int vt = 0; vt < 2; ++vt) { u32x2 o; o.x = cvt_pk_bf16(as[dt][vt][0], as[dt][vt][1]); o.y = cvt_pk_bf16(as[dt][vt][2], as[dt][vt][3]);
            *(LAS u32x2*)(ST + (16 * vt + l15) * 528 + (32 * w + 16 * dt + 4 * lq) * 2) = o; }
    __syncthreads();
}
__device__ __forceinline__ void scan_phase(Frame& F, const bf16_t* Q, const bf16_t* P, const bf16_t* KT, const bf16_t* VT, bf16_t* O, unsigned long long* stats, bool do_stats = true) {
    const int l15 = F.lane & 15, lq = F.lane >> 4, w = F.wave;
    LAS unsigned char* ST = F.lds;
    for (int uidx = blockIdx.x; uidx < 256; uidx += F.G) {
        const int x8 = uidx & 7, li = uidx >> 3, p = 2 * x8 + (li >> 4), slice = li & 15, b = p >> 2, h = p & 3;
        const float l2g = l2gamma(h), cdk = __builtin_amdgcn_exp2f(128.0f * l2g), crd = __builtin_amdgcn_exp2f((float)(16 * w + l15 + 1) * l2g);
        f32x4 as[2][2];
#pragma unroll
        for (int a = 0; a < 2; ++a)
#pragma unroll
            for (int c = 0; c < 2; ++c) as[a][c] = (f32x4){0.f, 0.f, 0.f, 0.f};
        for (int i = F.tid; i < 32 * 528 / 16; i += 512) ((LAS u32x4*)ST)[i] = (u32x4){0u, 0u, 0u, 0u};
        __syncthreads();
        const size_t tb0 = (size_t)b * SEQ;
        ScanPtrs sp;
        sp.qrow = Q + ((tb0 / 16 + w) * 32 + 8 * h) * 512 + F.lane * 8;
        sp.prow = P + (size_t)((b * NH + h) * NCH) * 16384 + (w * 4) * 512 + F.lane * 8;
        sp.vrow0 = VT + (size_t)((b * NH + h) * NCH) * (DV * 128) + (size_t)(2 * slice * 4) * 512 + F.lane * 8;
        sp.krow0 = KT + (size_t)((b * NH + h) * NCH) * (DK * 128) + (size_t)(2 * w * 4) * 512 + F.lane * 8;
        sp.orow = O + ((tb0 / 16 + w) * 64 + 16 * h + slice) * 512 + ((lq >> 1) * 16 + l15) * 8 + 4 * (lq & 1);
        sp.st1 = stats + (size_t)((b * NH + h) * 2) * SEQ + 16 * w + l15;
        bf16x8 qf[8], pf[4], va[2][4], vb[2][4], kf[2][4];
        scan_load_v(va, sp, 0); scan_load_k(kf, sp, 0); scan_load_p(pf, sp, 0); scan_load_q(qf, sp, 0);
        for (int n = 0; n < NCH; n += 2) {
            scan_step(n, ST, sp, as, va, vb, kf, pf, qf, cdk, crd, l15, lq, w, do_stats);
            scan_step(n + 1, ST, sp, as, vb, va, kf, pf, qf, cdk, crd, l15, lq, w, do_stats);
        }
        if (do_stats) {
            unsigned long long* sg = stats + (size_t)((b * NH + h) * 2) * SEQ;
            for (int i = F.tid; i < SEQ; i += 512) { const f32x2 v = *(const LAS f32x2*)(ST + 32768 + (size_t)i * 8);
                atomicAdd(sg + i, (unsigned long long)__float2ll_rn(v.x * 16777216.0f)); atomicAdd(sg + SEQ + i, (unsigned long long)__float2ll_rn(v.y * 16777216.0f)); }
        }
        __syncthreads();
    }
}

struct Args { const float* in[12]; float* out; unsigned char* ws; int ph_lo, ph_hi; };
constexpr int N_PHASES = 17;

__global__ void __launch_bounds__(NWAVES * 64, 2) mk_fwd(Args args) {
    extern __shared__ __attribute__((aligned(16))) unsigned char lds_raw[];
    Frame F;
    F.lds = (LAS unsigned char*)lds_raw;
    F.tid = threadIdx.x; F.lane = F.tid & 63; F.wave = __builtin_amdgcn_readfirstlane(F.tid >> 6); F.G = gridDim.x;
#pragma unroll
    for (int i = 0; i < 12; ++i) F.in[i] = args.in[i];
    F.out = args.out; F.ws = args.ws;
    unsigned char* ws = args.ws;
    LAS unsigned char* xl = F.lds + XL_OFF;
    const float* x = F.in[0]; const int* pos = (const int*)F.in[1]; const float* ng = F.in[2];
    const float* pool_w = F.in[3]; const float* pool_scale = F.in[4]; const float* w_in = F.in[5]; const float* gn = F.in[6]; const float* w_out = F.in[7];
    const float* w_up = F.in[8]; const float* conv_w = F.in[9]; const float* conv_b = F.in[10]; const float* w_down = F.in[11];
    bf16_t* HN = (bf16_t*)(ws + WS_HN); float* XR = F.out;
    const int gwv = blockIdx.x * NWAVES + F.wave, NGW = F.G * NWAVES;
    const int lo = args.ph_lo, hi = args.ph_hi;
#define IN(k) (lo <= (k) && (k) < hi)
    volatile LAS unsigned* MISC = (volatile LAS unsigned*)(F.lds + MISC_OFF);
    if (F.tid < 64) MISC[F.tid] = 0u;
    __syncthreads();
    XcdBarrier bar; bar.bar = (unsigned*)(ws + WS_CTL) + CW_BAR; bar.x = 0; bar.st = nullptr;
    if (hi - lo > 1) bar = xcd_barrier_post((unsigned*)(ws + WS_CTL) + CW_BAR, MISC + 8);
#define SEAM(k) do { if (IN(k) && IN((k) + 1)) xcd_barrier(bar); } while (0)

    if (IN(0)) {
        constexpr int I_IN = (D / 64) * (RIN / 32), I_OUT = (VTOT / 64) * (D / 32), I_POOL = 4 * (256 / 64) * (256 / 32), I_UP = (D / 64) * (FF2 / 32), I_DN = (FF / 64) * (D / 32);
        constexpr int NIT = I_IN + I_OUT + I_POOL + I_UP + I_DN;
        for (int it = gwv; it < NIT; it += NGW) { int r = it;
            if (r < I_IN) { transpose_plain(F, w_in, D, RIN, (bf16_t*)(ws + WS_WIN), r); continue; } r -= I_IN;
            if (r < I_OUT) { transpose_plain(F, w_out, VTOT, D, (bf16_t*)(ws + WS_WOUT), r); continue; } r -= I_OUT;
            if (r < I_POOL) { const int g = r >> 5; transpose_plain(F, pool_w + (size_t)g * 65536, 256, 256, (bf16_t*)(ws + WS_WPOOL) + (size_t)g * 65536, r & 31); continue; } r -= I_POOL;
            if (r < I_UP) { transpose_up(F, w_up, (bf16_t*)(ws + WS_WUP0), r); continue; } r -= I_UP;
            transpose_plain(F, w_down, FF, D, (bf16_t*)(ws + WS_WDN0), r); }
        __syncthreads();
        for (int u = blockIdx.x; u < M / 64; u += F.G) pool_diff_unit(F, u, x, ng, (bf16_t*)(ws + WS_DIFF));
    }
    SEAM(0);
    if (IN(1)) {
        pg8::Gemm g{(const bf16_t*)(ws + WS_DIFF), (const bf16_t*)(ws + WS_WPOOL), M, D, 256, D, 256}; pg8::StaticOrder S; S.init(M, D, F.G, (int)blockIdx.x);
        pg8::EpiF32 E{(float*)(ws + WS_FA), D};
        pg8::gemm_phase<pg8::EpiF32>(F.lds, xl, g, S, E);
    }
    SEAM(1);
    if (IN(2)) resnorm_phase(F, (const float*)(ws + WS_FA), pool_scale, x, XR, ng + 1 * D, ng + 2 * D, HN);
    SEAM(2);
    if (IN(3)) {
        pg8::Gemm g{HN, (const bf16_t*)(ws + WS_WUP0), M, FF2, D, D, 0}; pg8::StaticOrder S; S.init(M, FF2, F.G, (int)blockIdx.x);
        pg8::EpiConvGlu E{(bf16_t*)(ws + WS_ACT), (float*)(ws + WS_HALO), conv_w, conv_b};
        pg8::gemm_phase<pg8::EpiConvGlu>(F.lds, xl, g, S, E);
    }
    SEAM(3);
    if (IN(4)) convfix_phase(F, (const float*)(ws + WS_HALO), conv_w, conv_b, (bf16_t*)(ws + WS_ACT));
    SEAM(4);
    if (IN(5)) {
        pg8::Gemm g{(const bf16_t*)(ws + WS_ACT), (const bf16_t*)(ws + WS_WDN0), M, D, FF, FF, 0}; pg8::StaticOrder S; S.init(M, D, F.G, (int)blockIdx.x);
        pg8::EpiF32 E{(float*)(ws + WS_FB), D};
        pg8::gemm_phase<pg8::EpiF32>(F.lds, xl, g, S, E);
    }
    SEAM(5);
    if (IN(6)) resnorm_phase(F, (const float*)(ws + WS_FB), nullptr, XR, XR, ng + 3 * D, ng + 4 * D, HN);
    SEAM(6);
    if (IN(7)) {
        pg8::Gemm g{HN, (const bf16_t*)(ws + WS_WIN), M, 4096, D, D, 0}; pg8::StaticOrder S; S.init(M, 4096, F.G, (int)blockIdx.x);
        pg8::EpiRetA E{(bf16_t*)(ws + WS_Q), (bf16_t*)(ws + WS_K), (bf16_t*)(ws + WS_KT), (bf16_t*)(ws + WS_VT), pos};
        pg8::gemm_phase<pg8::EpiRetA>(F.lds, xl, g, S, E);
    }
    SEAM(7);
    if (IN(8)) scores_phase(F, (const bf16_t*)(ws + WS_Q), (const bf16_t*)(ws + WS_K), (bf16_t*)(ws + WS_P));
    SEAM(8);
#ifdef PROBE_SCAN2
    if (IN(9)) { scan_phase(F, (const bf16_t*)(ws + WS_Q), (const bf16_t*)(ws + WS_P), (const bf16_t*)(ws + WS_KT), (const bf16_t*)(ws + WS_VT), (bf16_t*)(ws + WS_O), (unsigned long long*)(ws + WS_STATS), false); __syncthreads(); }
#endif
    if (IN(9)) scan_phase(F, (const bf16_t*)(ws + WS_Q), (const bf16_t*)(ws + WS_P), (const bf16_t*)(ws + WS_KT), (const bf16_t*)(ws + WS_VT), (bf16_t*)(ws + WS_O), (unsigned long long*)(ws + WS_STATS));
    SEAM(9);
    if (IN(10)) {
        constexpr int I_UP = (D / 64) * (FF2 / 32), I_DN = (FF / 64) * (D / 32);
        for (int it = gwv; it < I_UP + I_DN; it += NGW) {
            if (it < I_UP) transpose_up(F, w_up + (size_t)D * FF2, (bf16_t*)(ws + WS_WUP1), it);
            else transpose_plain(F, w_down + (size_t)FF * D, FF, D, (bf16_t*)(ws + WS_WDN1), it - I_UP); }
        __syncthreads();
        pg8::Gemm g{HN, (const bf16_t*)(ws + WS_WIN) + (size_t)4096 * D, M, VTOT, D, D, 0}; pg8::StaticOrder S; S.init(M, VTOT, F.G, (int)blockIdx.x);
        pg8::EpiRetB E{(const bf16_t*)(ws + WS_O), (const long long*)(ws + WS_STATS), gn, (bf16_t*)(ws + WS_Y)};
        pg8::gemm_phase<pg8::EpiRetB>(F.lds, xl, g, S, E);
    }
    SEAM(10);
    if (IN(11)) {
        pg8::Gemm g{(const bf16_t*)(ws + WS_Y), (const bf16_t*)(ws + WS_WOUT), M, D, VTOT, VTOT, 0}; pg8::StaticOrder S; S.init(M, D, F.G, (int)blockIdx.x);
        pg8::EpiF32 E{(float*)(ws + WS_FC), D};
        pg8::gemm_phase<pg8::EpiF32>(F.lds, xl, g, S, E);
    }
    SEAM(11);
    if (IN(12)) resnorm_phase(F, (const float*)(ws + WS_FC), nullptr, XR, XR, ng + 5 * D, ng + 6 * D, HN);
    SEAM(12);
    if (IN(13)) {
        pg8::Gemm g{HN, (const bf16_t*)(ws + WS_WUP1), M, FF2, D, D, 0}; pg8::StaticOrder S; S.init(M, FF2, F.G, (int)blockIdx.x);
        pg8::EpiConvGlu E{(bf16_t*)(ws + WS_ACT), (float*)(ws + WS_HALO), conv_w + 3 * FF2, conv_b + FF2};
        pg8::gemm_phase<pg8::EpiConvGlu>(F.lds, xl, g, S, E);
    }
    SEAM(13);
    if (IN(14)) convfix_phase(F, (const float*)(ws + WS_HALO), conv_w + 3 * FF2, conv_b + FF2, (bf16_t*)(ws + WS_ACT));
    SEAM(14);
    if (IN(15)) {
        pg8::Gemm g{(const bf16_t*)(ws + WS_ACT), (const bf16_t*)(ws + WS_WDN1), M, D, FF, FF, 0}; pg8::StaticOrder S; S.init(M, D, F.G, (int)blockIdx.x);
        pg8::EpiF32 E{(float*)(ws + WS_FB), D};
        pg8::gemm_phase<pg8::EpiF32>(F.lds, xl, g, S, E);
    }
    SEAM(15);
    if (IN(16)) resnorm_phase(F, (const float*)(ws + WS_FB), nullptr, XR, XR, ng + 7 * D, nullptr, nullptr);
#ifdef MK_DUMP
    if (IN(100)) { const bf16_t* b0 = (const bf16_t*)(ws + WS_Q); const bf16_t* b1 = (const bf16_t*)(ws + WS_K); const bf16_t* b2 = (const bf16_t*)(ws + WS_KT); const bf16_t* b3 = (const bf16_t*)(ws + WS_VT);
        for (size_t i = (size_t)blockIdx.x * 512 + F.tid; i < (size_t)M * D; i += (size_t)F.G * 512) XR[i] = bf2f(b0[i]) + bf2f(b1[i]) + bf2f(b2[i]) + bf2f(b3[i]) + bf2f(b3[(size_t)M * D + i]); }
    if (IN(101)) { const bf16_t* b0 = (const bf16_t*)(ws + WS_P);
        for (size_t i = (size_t)blockIdx.x * 512 + F.tid; i < (size_t)M * D; i += (size_t)F.G * 512) XR[i] = bf2f(b0[i & (16777216 - 1)]); }
    if (IN(102)) { const bf16_t* b0 = (const bf16_t*)(ws + WS_O); const long long* st = (const long long*)(ws + WS_STATS);
        for (size_t i = (size_t)blockIdx.x * 512 + F.tid; i < (size_t)M * D; i += (size_t)F.G * 512) XR[i] = bf2f(b0[i]) + bf2f(b0[(size_t)M * D + i]); }
    if (IN(103)) { const bf16_t* b0 = (const bf16_t*)(ws + WS_Y);
        for (size_t i = (size_t)blockIdx.x * 512 + F.tid; i < (size_t)M * D; i += (size_t)F.G * 512) XR[i] = bf2f(b0[i]) + bf2f(b0[(size_t)M * D + i]); }
#endif
#undef IN
}

extern "C" void kernel_launch(void* const* d_in, const int* in_sizes, int n_in, void* d_out, int out_size, void* d_ws, size_t ws_size, hipStream_t stream) {
    static int grid = 0;
    if (grid == 0) {
        if (n_in != 12 || in_sizes[0] != M * D || out_size != M * D || ws_size < WS_END) { fprintf(stderr, "kernel_launch: unexpected shapes (n_in %d, in0 %d, out %d, ws %zu)\n", n_in, n_in > 0 ? in_sizes[0] : -1, out_size, ws_size); grid = -1; return; }
        int dev = 0, cus = 0, per_cu = 0;
        if (hipGetDevice(&dev) != hipSuccess || hipDeviceGetAttribute(&cus, hipDeviceAttributeMultiprocessorCount, dev) != hipSuccess) { grid = -1; return; }
        if (hipFuncSetAttribute((const void*)mk_fwd, hipFuncAttributeMaxDynamicSharedMemorySize, LDS_BYTES) != hipSuccess) { fprintf(stderr, "kernel_launch: hipFuncSetAttribute failed\n"); grid = -1; return; }
        if (hipOccupancyMaxActiveBlocksPerMultiprocessor(&per_cu, (const void*)mk_fwd, NWAVES * 64, LDS_BYTES) != hipSuccess || per_cu < 1) { fprintf(stderr, "kernel_launch: occupancy query says %d\n", per_cu); (void)hipGetLastError(); grid = -1; return; }
        grid = cus;
    }
    if (grid < 0) return;
    (void)hipMemsetAsync((char*)d_ws + WS_CTL, 0, CTL_ZERO_BYTES, stream);
    Args a{};
    for (int i = 0; i < 12; ++i) a.in[i] = (const float*)d_in[i];
    a.out = (float*)d_out; a.ws = (unsigned char*)d_ws;
#ifndef MK_STOP
#define MK_STOP N_PHASES
#endif
#if MK_ONE_LAUNCH
    a.ph_lo = 0; a.ph_hi = MK_STOP;
    hipLaunchKernelGGL(mk_fwd, dim3(grid), dim3(NWAVES * 64), LDS_BYTES, stream, a);
#else
    for (int ph = 0; ph < MK_STOP; ++ph) {
        a.ph_lo = ph; a.ph_hi = ph + 1;
        hipLaunchKernelGGL(mk_fwd, dim3(grid), dim3(NWAVES * 64), LDS_BYTES, stream, a);
    }
#endif
#ifdef MK_DUMP
    a.ph_lo = MK_DUMP; a.ph_hi = MK_DUMP + 1; hipLaunchKernelGGL(mk_fwd, dim3(grid), dim3(NWAVES * 64), LDS_BYTES, stream, a);
#endif
}
```
